# Optimizing an MI355X kernel written in HIP

```python
import jax, jax.numpy as jnp
from jax import lax
import numpy as np

D_MODEL = 4096
BATCH = 4
SEQ = 4096
DEPTH = 1

MIX_WIDTH = D_MODEL
POOL_WIDTH = MIX_WIDTH // 2
FOURIER_WIDTH = MIX_WIDTH - POOL_WIDTH
POOL_WINDOWS = (2, 4, 8, 16)
POOL_GROUPS = len(POOL_WINDOWS)
POOL_GROUP_DIM = POOL_WIDTH // POOL_GROUPS
FOURIER_HEADS = 4
FOURIER_HEAD_DIM = FOURIER_WIDTH // FOURIER_HEADS

N_EXPERTS = 32
TOP_K = 4
D_FF = D_MODEL // 8
SWIGLU_LIMIT = 7.0
SWIGLU_ALPHA = 1.702

RMS_EPS = 1e-5

kernel_name = "hybrid_pool_fourier_moe_encoder"


def rmsnorm(x, g):
    xf = x.astype(jnp.float32)
    y = xf * lax.rsqrt(jnp.mean(xf * xf, axis=-1, keepdims=True) + RMS_EPS)
    return (y * g.astype(jnp.float32)).astype(x.dtype)


def pool_mixer(u, pool_w, pool_scale):
    B, S, _ = u.shape
    uf = u.astype(jnp.float32)
    cs = jnp.concatenate([jnp.zeros((B, 1, POOL_WIDTH), jnp.float32), jnp.cumsum(uf, axis=1)], axis=1)
    t = jnp.arange(S)
    outs = []
    for g, w in enumerate(POOL_WINDOWS):
        lo = jnp.maximum(t - w // 2, 0)
        hi = jnp.minimum(t + w // 2 - 1, S - 1)
        csg = cs[:, :, g * POOL_GROUP_DIM:(g + 1) * POOL_GROUP_DIM]
        win_sum = jnp.take(csg, hi + 1, axis=1) - jnp.take(csg, lo, axis=1)
        cnt = (hi - lo + 1).astype(jnp.float32)[None, :, None]
        outs.append(win_sum / cnt - uf[:, :, g * POOL_GROUP_DIM:(g + 1) * POOL_GROUP_DIM])
    p = jnp.stack(outs, axis=2)
    y = jnp.einsum('bsgc,gcd->bsgd', p, pool_w.astype(jnp.float32)).reshape(B, S, POOL_WIDTH)
    return (y * pool_scale.astype(jnp.float32)).astype(u.dtype)


def fourier_mixer(u, fourier_w):
    B, S, _ = u.shape
    v = u.astype(jnp.float32).reshape(B, S, FOURIER_HEADS, FOURIER_HEAD_DIM)
    f = jnp.fft.fft2(v, axes=(1, 3), norm="ortho").real
    y = jnp.einsum('bshc,hcd->bshd', f, fourier_w.astype(jnp.float32)).reshape(B, S, FOURIER_WIDTH)
    return y.astype(u.dtype)


def moe_ffn(z, router_w, router_b, w_gate, b_gate, w_up, b_up, w_down, b_down):
    B, S, D = z.shape
    N = B * S
    zf = z.reshape(N, D)
    logits = jnp.dot(zf.astype(jnp.float32), router_w.astype(jnp.float32)) + router_b.astype(jnp.float32)
    top_v, top_i = lax.top_k(logits, TOP_K)
    gates = jax.nn.softmax(top_v, axis=-1)
    gate_dense = jnp.sum(jax.nn.one_hot(top_i, N_EXPERTS, dtype=jnp.float32) * gates[..., None], axis=1)
    hg = jnp.einsum('nd,edf->nef', zf, w_gate) + b_gate[None]
    hu = jnp.einsum('nd,edf->nef', zf, w_up) + b_up[None]
    hg = jnp.minimum(hg, SWIGLU_LIMIT)
    hu = jnp.clip(hu, -SWIGLU_LIMIT, SWIGLU_LIMIT)
    act = hg * jax.nn.sigmoid(SWIGLU_ALPHA * hg) * (hu + 1.0)
    act = act * gate_dense.astype(act.dtype)[:, :, None]
    y = jnp.einsum('nef,efd->nd', act, w_down) + jnp.dot(gate_dense.astype(b_down.dtype), b_down)
    return y.reshape(B, S, D).astype(z.dtype)


def setup_inputs(seed: int = 0) -> dict:
    key = jax.random.key(seed)
    ks = jax.random.split(key, 20)
    f32 = jnp.float32
    nrm = lambda k, shape, scale: jax.random.normal(k, shape, f32) * scale
    L = DEPTH
    return {
        "x": jax.random.normal(ks[0], (BATCH, SEQ, D_MODEL), f32),
        "norm1_g": 1.0 + nrm(ks[1], (L, D_MODEL), 0.05),
        "w_in": nrm(ks[2], (L, D_MODEL, MIX_WIDTH), D_MODEL ** -0.5),
        "pool_w": nrm(ks[3], (L, POOL_GROUPS, POOL_GROUP_DIM, POOL_GROUP_DIM), POOL_GROUP_DIM ** -0.5),
        "pool_scale": 1.0 + nrm(ks[4], (L, POOL_WIDTH), 0.1),
        "fourier_w": nrm(ks[5], (L, FOURIER_HEADS, FOURIER_HEAD_DIM, FOURIER_HEAD_DIM), FOURIER_HEAD_DIM ** -0.5),
        "w_out": nrm(ks[6], (L, MIX_WIDTH, D_MODEL), MIX_WIDTH ** -0.5),
        "norm2_g": 1.0 + nrm(ks[7], (L, D_MODEL), 0.05),
        "router_w": nrm(ks[8], (L, D_MODEL, N_EXPERTS), D_MODEL ** -0.5),
        "router_b": nrm(ks[9], (L, N_EXPERTS), 0.01),
        "w_gate": nrm(ks[10], (L, N_EXPERTS, D_MODEL, D_FF), D_MODEL ** -0.5),
        "b_gate": nrm(ks[11], (L, N_EXPERTS, D_FF), 0.01),
        "w_up": nrm(ks[12], (L, N_EXPERTS, D_MODEL, D_FF), D_MODEL ** -0.5),
        "b_up": nrm(ks[13], (L, N_EXPERTS, D_FF), 0.01),
        "w_down": nrm(ks[14], (L, N_EXPERTS, D_FF, D_MODEL), D_FF ** -0.5),
        "b_down": nrm(ks[15], (L, N_EXPERTS, D_MODEL), 0.01),
        "final_g": 1.0 + nrm(ks[16], (D_MODEL,), 0.05),
    }


def reference(x, norm1_g, w_in, pool_w, pool_scale, fourier_w, w_out, norm2_g,
              router_w, router_b, w_gate, b_gate, w_up, b_up, w_down, b_down, final_g):
    h = x
    for l in range(DEPTH):
        z = rmsnorm(h, norm1_g[l])
        u = jnp.einsum('bsd,dm->bsm', z, w_in[l])
        a = pool_mixer(u[..., :POOL_WIDTH], pool_w[l], pool_scale[l])
        f = fourier_mixer(u[..., POOL_WIDTH:], fourier_w[l])
        mixed = jnp.concatenate([a, f], axis=-1)
        h = h + jnp.einsum('bsm,md->bsd', mixed, w_out[l])
        z2 = rmsnorm(h, norm2_g[l])
        h = h + moe_ffn(z2, router_w[l], router_b[l], w_gate[l], b_gate[l],
                        w_up[l], b_up[l], w_down[l], b_down[l])
    return rmsnorm(h, final_g)
```

```cpp
#include <hip/hip_runtime.h>
#include <stdio.h>
#include <stdint.h>

#ifndef MK_DOUBLE
#define MK_DOUBLE -1
#endif
#ifndef MK_PER_PHASE
#define MK_PER_PHASE 0
#endif
static_assert(MK_PER_PHASE == 0, "phases 5 and 9 synchronise inside the launch: build the one-launch form");

#define LAS __attribute__((address_space(3)))
typedef unsigned short bf16_t;
typedef short bf16x8 __attribute__((ext_vector_type(8)));
typedef float f32x4 __attribute__((ext_vector_type(4)));
typedef float f32x2 __attribute__((ext_vector_type(2)));
typedef unsigned u32x4 __attribute__((ext_vector_type(4)));
typedef unsigned u32x2 __attribute__((ext_vector_type(2)));

constexpr int DM = 4096, SEQ = 4096, NBATCH = 4, NTOK = NBATCH * SEQ;
constexpr int NE = 32, DFF = 512, CAP = 16384;
constexpr float RMS_EPS = 1e-5f;
constexpr int NTHREADS = 512, NPHASES = 11;

constexpr size_t MiB = 1ull << 20;
constexpr size_t WS_CTL = 0;
constexpr size_t CTL_BYTES = 65536;
constexpr size_t CTL_CNT = 16384;
constexpr size_t WS_RSTD1 = 65536;
constexpr size_t WS_ROWTOK = 1 * MiB;
constexpr size_t WS_ROWRSTD = 3 * MiB;
constexpr size_t WS_ROWGATE = 5 * MiB;
constexpr size_t WS_ROWDST = 7 * MiB;
constexpr size_t WS_PWT = 9 * MiB;
constexpr size_t WS_FWT = 11 * MiB;
constexpr size_t WS_DFTC = 13 * MiB;
constexpr size_t WS_GT = 14 * MiB;
constexpr size_t WS_RWT = 18 * MiB;
constexpr size_t WS_WGU = 20 * MiB;
constexpr size_t WS_WD = 148 * MiB;
constexpr size_t WS_H1B = 212 * MiB;
constexpr size_t WS_H1F8 = 340 * MiB;
constexpr size_t WS_ACT = 404 * MiB;
constexpr size_t WS_TABG = 437 * MiB;
constexpr size_t WS_E = 440 * MiB;
constexpr size_t E_XB = WS_E;
constexpr size_t E_MIXED = WS_E + 512 * MiB;
constexpr size_t E_WINT = WS_E + 128 * MiB;
constexpr size_t E_HM = E_WINT;
constexpr size_t E_WOUTT = WS_E + 160 * MiB;
constexpr size_t E_U = WS_E + 192 * MiB;
constexpr size_t E_VEVO = WS_E + 320 * MiB;
constexpr size_t E_QT = WS_E + 448 * MiB;
constexpr size_t E_T = E_U;
constexpr size_t E_WINP = E_QT;
constexpr size_t E_Y = WS_E;
constexpr size_t WS_END = WS_E + 640 * MiB;

constexpr int LDS_STAGE = 131072;
constexpr int LX_BAR = LDS_STAGE;
constexpr int LX_TAB = LDS_STAGE + 256;
constexpr int LX_RT = LDS_STAGE + 4096;
constexpr int LDS_BYTES = LDS_STAGE + 16384;

__device__ __forceinline__ unsigned cvt_pk_bf16(float lo, float hi) { unsigned r; asm("v_cvt_pk_bf16_f32 %0, %1, %2" : "=v"(r) : "v"(lo), "v"(hi)); return r; }
__device__ __forceinline__ float bf_lo(unsigned w) { return __uint_as_float(w << 16); }
__device__ __forceinline__ float bf_hi(unsigned w) { return __uint_as_float(w & 0xffff0000u); }
__device__ __forceinline__ u32x4 pack8(const f32x4 a, const f32x4 b) { u32x4 w; w.x = cvt_pk_bf16(a[0], a[1]); w.y = cvt_pk_bf16(a[2], a[3]); w.z = cvt_pk_bf16(b[0], b[1]); w.w = cvt_pk_bf16(b[2], b[3]); return w; }
__device__ __forceinline__ float wave_sum(float v) {
#pragma unroll
    for (int o = 32; o >= 1; o >>= 1) v += __shfl_xor(v, o);
    return v;
}

#define XB_TMO      128
#define XB_XCNT(j)  (256  + 64 * (j))
#define XB_XSUB(j)  (1280 + 64 * (j))
#define XB_XGEN(j)  (2304 + 64 * (j))
#define XB_TOP      3328
#define XB_TOPGEN   3392
#define XCD_BAR_WORDS 3456
#define XB_SPIN_CAP (1u << 18)
__device__ __forceinline__ unsigned xb_ld(unsigned* p)              { return __hip_atomic_load(p, __ATOMIC_RELAXED, __HIP_MEMORY_SCOPE_AGENT); }
__device__ __forceinline__ unsigned xb_add(unsigned* p, unsigned v) { return __hip_atomic_fetch_add(p, v, __ATOMIC_RELAXED, __HIP_MEMORY_SCOPE_AGENT); }
__device__ __forceinline__ unsigned xb_xcc_id() { return (unsigned)__builtin_amdgcn_s_getreg((3 << 11) | 20) & 0xFu; }
#define XB_SPIN(cond, bar) do { unsigned _sp = 0; while (cond) { __builtin_amdgcn_s_sleep(1); \
    if ((++_sp & 255u) == 0u) { if (xb_ld(&(bar)[XB_TMO])) break; if (_sp > XB_SPIN_CAP) { atomicAdd(&(bar)[XB_TMO], 1u); break; } } } } while (0)
struct XcdBarrier { unsigned* bar; unsigned x; volatile LAS unsigned* st; };
__device__ __forceinline__ XcdBarrier xcd_barrier_post(unsigned* bar, volatile LAS unsigned* st) {
    XcdBarrier b; b.bar = bar; b.x = xb_xcc_id(); b.st = st;
    if (threadIdx.x == 0) (void)xb_add(&bar[XB_XCNT(b.x)], 1u);
    return b;
}
__device__ __forceinline__ void xcd_barrier_complete(unsigned* bar, unsigned x, unsigned& nloc, unsigned& nx) {
    const unsigned G = gridDim.x * gridDim.y * gridDim.z;
    unsigned sum, cnt, mine, sp = 0u;
    for (;;) {
        sum = 0u; cnt = 0u; mine = 0u;
#pragma unroll
        for (unsigned j = 0; j < 16; ++j) { const unsigned c = xb_ld(&bar[XB_XCNT(j)]); sum += c; cnt += (c > 0u) ? 1u : 0u; mine = (j == x) ? c : mine; }
        if (sum == G) break;
        __builtin_amdgcn_s_sleep(1);
        if ((++sp & 255u) == 0u) { if (xb_ld(&bar[XB_TMO])) break; if (sp > XB_SPIN_CAP) { atomicAdd(&bar[XB_TMO], 1u); break; } }
    }
    nloc = mine > 0u ? mine : 1u; nx = cnt > 0u ? cnt : 1u;
}
__device__ __forceinline__ void xcd_barrier(const XcdBarrier& b, const bool leader) {
    asm volatile("s_waitcnt vmcnt(0)" ::: "memory");
    __syncthreads();
    if (leader) {
        unsigned* bar = b.bar;
        __builtin_amdgcn_s_waitcnt(0);
        unsigned nloc = b.st[0], nx = b.st[1];
        if (nloc == 0u) { xcd_barrier_complete(bar, b.x, nloc, nx); b.st[0] = nloc; b.st[1] = nx; }
        const unsigned old = xb_add(&bar[XB_XSUB(b.x)], 1u);
        const unsigned gen = old / nloc;
        if (old + 1u == (gen + 1u) * nloc) {
            __builtin_amdgcn_fence(__ATOMIC_RELEASE, "agent");
            asm volatile("s_waitcnt vmcnt(0)" ::: "memory");
            const unsigned og = xb_add(&bar[XB_TOP], 1u);
            const unsigned tg = og / nx;
            if (og + 1u == (tg + 1u) * nx) xb_add(&bar[XB_TOPGEN], 1u);
            else XB_SPIN(xb_ld(&bar[XB_TOPGEN]) == tg, bar);
            __builtin_amdgcn_fence(__ATOMIC_ACQUIRE, "agent");
            xb_add(&bar[XB_XGEN(b.x)], 1u);
            asm volatile("s_waitcnt vmcnt(0)" ::: "memory");
        } else {
            XB_SPIN(xb_ld(&bar[XB_XGEN(b.x)]) == gen, bar);
            __builtin_amdgcn_fence(__ATOMIC_ACQUIRE, "agent");
            asm volatile("s_waitcnt vmcnt(0)" ::: "memory");
        }
    }
    __syncthreads();
}

namespace g8 {
constexpr int BM = 256, BK = 64, HALF = 128, HTB = HALF * BK * 2, NXCD = 8, WGM = 8;
__device__ __forceinline__ int lds_byte(int r, int c) { const int st = (r >> 4) * 2 + (c >> 5), rr = r & 15, cc = c & 31, ob = rr * 64 + cc * 2; return st * 1024 + (ob ^ (((ob >> 9) & 1) << 5)); }
__device__ __forceinline__ void stage_rc(int b, int& R, int& C) { const int st = b / 1024, sb = b % 1024, swz = sb ^ (((sb >> 9) & 1) << 5); R = (st >> 1) * 16 + swz / 64; C = (st & 1) * 32 + (swz % 64) / 2; }
__device__ __forceinline__ int perm32(int rho) { const int n = rho >> 4, i = rho & 15; return 8 * (i >> 2) + 4 * n + (i & 3); }

struct Unit { int pm, pn, e, mt, cnt, rb; };

__device__ __forceinline__ bool tile_of_L(long L, int nM, int nN, int& pm, int& pn) {
    const int nwg = nM * nN; if (L >= nwg) return false;
    int wgid = (int)L; { const int q = nwg / NXCD, r = nwg % NXCD, xcd = wgid % NXCD, off = wgid / NXCD; wgid = (xcd < r ? xcd * (q + 1) : r * (q + 1) + (xcd - r) * q) + off; }
    const int nig = WGM * nN, gid = wgid / nig, fm = gid * WGM, gsz = (nM - fm) < WGM ? (nM - fm) : WGM;
    pm = fm + ((wgid % nig) % gsz); pn = (wgid % nig) / gsz; return true;
}
__device__ __forceinline__ bool static_tile(int i, int G, int c, int nM, int nN, int& pm, int& pn) { return tile_of_L((long)i * G + c, nM, nN, pm, pn); }

typedef f32x4 Acc[2][2][4][2];
__device__ __forceinline__ int lane_id_v() { int l; asm volatile("v_mbcnt_lo_u32_b32 %0, -1, 0\n\tv_mbcnt_hi_u32_b32 %0, -1, %0" : "=&v"(l)); return l; }
typedef int i32x8 __attribute__((ext_vector_type(8)));
typedef int i32x4 __attribute__((ext_vector_type(4)));
__device__ __forceinline__ i32x8 cat8(bf16x8 a, bf16x8 b) { const i32x4 x = __builtin_bit_cast(i32x4, a), y = __builtin_bit_cast(i32x4, b); return __builtin_shufflevector(x, y, 0, 1, 2, 3, 4, 5, 6, 7); }
__device__ __forceinline__ u32x2 pack8_fp8(const f32x4 a, const f32x4 b) { int w0 = 0, w1 = 0;
    w0 = __builtin_amdgcn_cvt_pk_fp8_f32(a[0], a[1], w0, false); w0 = __builtin_amdgcn_cvt_pk_fp8_f32(a[2], a[3], w0, true);
    w1 = __builtin_amdgcn_cvt_pk_fp8_f32(b[0], b[1], w1, false); w1 = __builtin_amdgcn_cvt_pk_fp8_f32(b[2], b[3], w1, true);
    u32x2 r; r.x = (unsigned)w0; r.y = (unsigned)w1; return r; }

template <int N> __device__ __forceinline__ void wait_vm() { static_assert(N >= 0 && N < 64, "vmcnt is a 6-bit counter"); asm volatile("s_waitcnt vmcnt(%0)" :: "n"(N) : "memory"); }
template <class P>
__device__ __forceinline__ void gemm_phase(LAS unsigned char* lds, const P& p, const int wid) {
    constexpr int SX = P::STREAM != 0 ? 2 : 0;
    const int lane = (int)__builtin_amdgcn_mbcnt_hi(~0u, __builtin_amdgcn_mbcnt_lo(~0u, 0u)), tid = wid * 64 + lane, wr = wid >> 2, wc = wid & 3, fr = lane & 15, fq = lane >> 4;
    const int nt = p.nt;
    int Rr0, Cc0; stage_rc(tid * 16, Rr0, Cc0);
    const unsigned voffA = (unsigned)Rr0 * p.lda2 + (unsigned)Cc0 * 2u, voffB = (unsigned)(64 * (Rr0 >> 5) + 16 * ((Rr0 & 15) >> 2) + 4 * ((Rr0 >> 4) & 1) + (Rr0 & 3)) * p.ldb2 + (unsigned)Cc0 * 2u;
    const unsigned pstepA = 64u * p.lda2, pstepB = 128u * p.ldb2;
    const unsigned kstep = (unsigned)(BK * 2);
    const unsigned hstepA = (unsigned)HALF * p.lda2, hstepB = 8u * p.ldb2;
    const unsigned ldsw = ((unsigned)wid * 1024u) & 0x1c00u;
    const int aoff = lds_byte(wr * 64 + fr, fq * 8) & 0x3ff0, boff = lds_byte(wc * 32 + fr, fq * 8) & 0x3ff0;
    unsigned abase = (unsigned)(size_t)lds + (unsigned)aoff, bbase = (unsigned)(size_t)lds + 65536u + (unsigned)boff;
    int scale1 = 0x7f7f7f7f; asm volatile("" : "+v"(scale1));
    unsigned cvA[2][2], nvA[2][2];
    const __amdgpu_buffer_rsrc_t rsA = __builtin_amdgcn_make_buffer_rsrc((void*)p.A, (short)0, (int)0xFFFFFF00u, 0x00020000);
    const __amdgpu_buffer_rsrc_t rsB = __builtin_amdgcn_make_buffer_rsrc((void*)p.B, (short)0, (int)0xFFFFFF00u, 0x00020000);
#define G8_SA(b, h) (((b) * 2 + (h)) * HTB)
#define G8_SB(b, h) ((4 + (b) * 2 + (h)) * HTB)
#define G8_STAGE_B(bufoff, soff, h) do { const unsigned _so = (unsigned)(soff) + (unsigned)(h) * hstepB; _Pragma("unroll") for (int _i = 0; _i < 2; ++_i) \
        __builtin_amdgcn_raw_ptr_buffer_load_lds(rsB, (LAS void*)(lds + (bufoff) + ldsw + _i * 8192), 16, (int)voffB, (int)(_so + _i * pstepB), 0, 0); } while (0)
#define G8_STAGE_A(bufoff, soff, h, NX) do { \
        if constexpr (P::GATHER) { _Pragma("unroll") for (int _i = 0; _i < 2; ++_i) { const unsigned _o = (NX) ? nvA[h][_i] : cvA[h][_i]; \
            __builtin_amdgcn_raw_ptr_buffer_load_lds(rsA, (LAS void*)(lds + (bufoff) + ldsw + _i * 8192), 16, (int)_o, (int)(unsigned)(soff), 0, 0); } } \
        else { const unsigned _so = (unsigned)(soff) + (unsigned)(h) * hstepA; _Pragma("unroll") for (int _i = 0; _i < 2; ++_i) \
            __builtin_amdgcn_raw_ptr_buffer_load_lds(rsA, (LAS void*)(lds + (bufoff) + ldsw + _i * 8192), 16, (int)voffA, (int)(_so + _i * pstepA), 0, 0); } } while (0)
#define G8_FA(b, h, m, k) (*(const LAS bf16x8*)(lds + aoff + (G8_SA(b, h) + (m) * 2048 + (k) * 1024)))
#define G8_FB(b, h, n, k) (*(const LAS bf16x8*)(lds + boff + (G8_SB(b, h) + (n) * 2048 + (k) * 1024)))
#define G8_RD(dst, base, off) asm volatile("ds_read_b128 %0, %1 offset:%2" : "=v"(dst) : "v"(base), "i"(off))
#define G8_LDA(dst, b, h) do { _Pragma("unroll") for (int m = 0; m < 4; ++m) _Pragma("unroll") for (int k = 0; k < 2; ++k) { \
        if constexpr (P::FP8) G8_RD(dst[m][k], abase, G8_SA(b, h) + m * 2048 + k * 1024); else dst[m][k] = G8_FA(b, h, m, k); } } while (0)
#define G8_LDB(dst, b, h) do { _Pragma("unroll") for (int n = 0; n < 2; ++n) _Pragma("unroll") for (int k = 0; k < 2; ++k) { \
        if constexpr (P::FP8) G8_RD(dst[n][k], bbase, G8_SB(b, h) - 65536 + n * 2048 + k * 1024); else dst[n][k] = G8_FB(b, h, n, k); } } while (0)
#define G8_WAIT_L_AB() do { if constexpr (P::FP8) asm volatile("s_waitcnt lgkmcnt(0)" : "+v"(B0[0][0]), "+v"(B0[0][1]), "+v"(B0[1][0]), "+v"(B0[1][1]), "+v"(B1[0][0]), "+v"(B1[0][1]), "+v"(B1[1][0]), "+v"(B1[1][1]), \
            "+v"(At[0][0]), "+v"(At[0][1]), "+v"(At[1][0]), "+v"(At[1][1]), "+v"(At[2][0]), "+v"(At[2][1]), "+v"(At[3][0]), "+v"(At[3][1])); else G8_WAIT_L(0); } while (0)
#define G8_WAIT_L_A() do { if constexpr (P::FP8) asm volatile("s_waitcnt lgkmcnt(0)" : "+v"(At[0][0]), "+v"(At[0][1]), "+v"(At[1][0]), "+v"(At[1][1]), "+v"(At[2][0]), "+v"(At[2][1]), "+v"(At[3][0]), "+v"(At[3][1])); else G8_WAIT_L(0); } while (0)
#define G8_MMA(ai, bj, At, Bt) do { __builtin_amdgcn_s_setprio(1); _Pragma("unroll") for (int m = 0; m < 4; ++m) _Pragma("unroll") for (int n = 0; n < 2; ++n) { \
        if constexpr (P::FP8) asm volatile("v_mfma_scale_f32_16x16x128_f8f6f4 %0, %1, %2, %0, %3, %3 op_sel_hi:[0,0,0]" : "+v"(acc[ai][bj][m][n]) : "v"(cat8(Bt[n][0], Bt[n][1])), "v"(cat8(At[m][0], At[m][1])), "v"(scale1)); \
        else { _Pragma("unroll") for (int k = 0; k < 2; ++k) asm volatile("v_mfma_f32_16x16x32_bf16 %0, %1, %2, %0" : "+v"(acc[ai][bj][m][n]) : "v"(Bt[n][k]), "v"(At[m][k])); } } \
        __builtin_amdgcn_s_setprio(0); } while (0)
#define G8_MMA0(ai, bj, At, Bt) do { __builtin_amdgcn_s_setprio(1); _Pragma("unroll") for (int m = 0; m < 4; ++m) _Pragma("unroll") for (int n = 0; n < 2; ++n) { \
        if constexpr (P::FP8) asm volatile("v_mfma_scale_f32_16x16x128_f8f6f4 %0, %1, %2, 0, %3, %3 op_sel_hi:[0,0,0]" : "+v"(acc[ai][bj][m][n]) : "v"(cat8(Bt[n][0], Bt[n][1])), "v"(cat8(At[m][0], At[m][1])), "v"(scale1)); \
        else { asm volatile("v_mfma_f32_16x16x32_bf16 %0, %1, %2, 0" : "+v"(acc[ai][bj][m][n]) : "v"(Bt[n][0]), "v"(At[m][0])); \
               asm volatile("v_mfma_f32_16x16x32_bf16 %0, %1, %2, %0" : "+v"(acc[ai][bj][m][n]) : "v"(Bt[n][1]), "v"(At[m][1])); } } \
        __builtin_amdgcn_s_setprio(0); } while (0)
#define G8_MMAF(ai, bj, At, Bt, FIRST) do { if (FIRST) G8_MMA0(ai, bj, At, Bt); else G8_MMA(ai, bj, At, Bt); } while (0)
#define G8_WAIT_V(n) asm volatile("s_waitcnt vmcnt(" #n ")" ::: "memory")
#define G8_WAIT_L(n) asm volatile("s_waitcnt lgkmcnt(" #n ")" ::: "memory")
#define G8_BAR __builtin_amdgcn_s_barrier()
#define G8_SCHED __builtin_amdgcn_sched_barrier(0)
    Unit cur, nxt; int ui = 0;
    if (!p.next(0, cur)) return;
    int l2pf[1] = {0};
    unsigned strip = 0; int sacc[4] = {0, 0, 0, 0};
    Acc acc;
#pragma unroll
    for (int a = 0; a < 2; ++a)
#pragma unroll
        for (int b = 0; b < 2; ++b)
#pragma unroll
            for (int m = 0; m < 4; ++m)
#pragma unroll
                for (int n = 0; n < 2; ++n) acc[a][b][m][n] = (f32x4){0.f, 0.f, 0.f, 0.f};
    bf16x8 At[4][2], B0[2][2], B1[2][2];
    typename P::Pre pre;
    unsigned cA = __builtin_amdgcn_readfirstlane(p.a_off(cur)), cB = __builtin_amdgcn_readfirstlane(p.b_off(cur));
    if constexpr (P::GATHER) { p.a_rows(cur, wid, cvA); p.a_rows_fin(wid, cvA); asm volatile("" : "+v"(cvA[0][0]), "+v"(cvA[0][1]), "+v"(cvA[1][0]), "+v"(cvA[1][1])); }
    G8_STAGE_B(G8_SB(0, 0), cB, 0); G8_STAGE_B(G8_SB(0, 1), cB, 1); G8_STAGE_A(G8_SA(0, 0), cA, 0, false); G8_STAGE_A(G8_SA(0, 1), cA, 1, false);
    if (wr == 1) G8_BAR;
    G8_WAIT_V(2); G8_BAR;
    G8_STAGE_B(G8_SB(1, 0), cB + kstep, 0); G8_STAGE_A(G8_SA(1, 0), cA + kstep, 0, false); G8_STAGE_B(G8_SB(1, 1), cB + kstep, 1);
    G8_WAIT_V(6); G8_BAR;
    for (;;) {
        p.prefetch(cur, wid, pre);
        const bool has_next = p.next(ui + 1, nxt);
        const unsigned nA = __builtin_amdgcn_readfirstlane(has_next ? p.a_off(nxt) : cA), nB = __builtin_amdgcn_readfirstlane(has_next ? p.b_off(nxt) : cB);
        if constexpr (P::GATHER) { Unit ar; ar.pm = has_next ? nxt.pm : cur.pm; ar.pn = has_next ? nxt.pn : cur.pn; ar.e = has_next ? nxt.e : cur.e; ar.mt = has_next ? nxt.mt : cur.mt; ar.cnt = has_next ? nxt.cnt : cur.cnt; ar.rb = has_next ? nxt.rb : cur.rb;
            p.a_rows(ar, wid, nvA); }
#define G8_TRIP(TT, FIRST) do { \
            const int t = (TT); const bool last = (FIRST) ? false : (t == nt - 2);        \
            const unsigned a1 = cA + (unsigned)(t + 1) * kstep; \
            const unsigned a2 = last ? nA : cA + (unsigned)(t + 2) * kstep, b2 = last ? nB : cB + (unsigned)(t + 2) * kstep; \
            const unsigned a3 = a2 + kstep, b3 = b2 + kstep; \
            G8_LDB(B0, 0, 0); G8_LDB(B1, 0, 1); G8_SCHED; G8_LDA(At, 0, 0); G8_STAGE_A(G8_SA(1, 1), a1, 1, false); \
            f32x4 se0, se1; bool sval = false; int srq = 0, scc = 0, stI = 0; \
            if constexpr (P::STREAM != 0) { \
                const int sk = (int)(strip >> 2), sph = (int)(strip & 3u); \
                sval = sk < p.sk1; stI = sval ? p.sbid + sk * p.G : 0; \
                const int bi = wid * 2 + (sph >> 1); srq = (bi >> 2) * 8 + (lane >> 3); scc = (bi & 3) * 8 + (lane & 7); \
                const float* sp; int sld; \
                if constexpr (P::STREAM == 1) { const int q = stI & 4095, e = q >> 7, r = q & 127, kt = r >> 2, pn = r & 3; sld = 512; \
                    sp = (stI >= 4096 ? p.ssrc1 : p.ssrc0) + (size_t)e * 4096 * 512 + (size_t)kt * 128 * 512 + pn * 128; } \
                else { const int e = stI >> 7, r = stI & 127, ft = r >> 5, dt = r & 31; sld = 4096; \
                    sp = p.ssrc0 + (size_t)e * 512 * 4096 + (size_t)ft * 128 * 4096 + dt * 128; } \
                sp += (size_t)(4 * srq + 2 * (sph & 1)) * sld + scc * 4; \
                se0 = __builtin_nontemporal_load((const f32x4*)sp); se1 = __builtin_nontemporal_load((const f32x4*)(sp + sld)); \
            } \
            if (FIRST) { if (ui == 0) wait_vm<8 + SX + P::NPF>(); else wait_vm<8 + SX + P::NPF + P::NS>(); } else wait_vm<8 + SX>(); \
            G8_WAIT_L_AB(); G8_BAR; G8_MMAF(0, 0, At, B0, FIRST); G8_MMAF(0, 1, At, B1, FIRST); G8_BAR; G8_SCHED; \
            G8_LDA(At, 0, 1); G8_STAGE_B(G8_SB(0, 0), b2, 0); G8_STAGE_B(G8_SB(0, 1), b2, 1); G8_STAGE_A(G8_SA(0, 0), a2, 0, last); \
            if (FIRST) { if (ui == 0) wait_vm<8 + SX + P::NPF>(); else wait_vm<8 + SX + P::NPF + P::NS>(); } else wait_vm<8 + SX>(); \
            G8_WAIT_L_A(); G8_BAR; G8_MMAF(1, 0, At, B0, FIRST); G8_MMAF(1, 1, At, B1, FIRST); G8_BAR; G8_SCHED; \
            G8_LDB(B0, 1, 0); G8_LDB(B1, 1, 1); G8_SCHED; G8_LDA(At, 1, 0); G8_STAGE_A(G8_SA(0, 1), a2, 1, last); \
            wait_vm<8 + SX>(); \
            G8_WAIT_L_AB(); G8_BAR; G8_MMA(0, 0, At, B0); G8_MMA(0, 1, At, B1); G8_BAR; G8_SCHED; \
            G8_LDA(At, 1, 1); G8_STAGE_B(G8_SB(1, 0), b3, 0); G8_STAGE_B(G8_SB(1, 1), b3, 1); G8_STAGE_A(G8_SA(1, 0), a3, 0, last); \
            wait_vm<8>(); G8_WAIT_L_A(); G8_BAR; G8_MMA(1, 0, At, B0); G8_MMA(1, 1, At, B1); G8_BAR; G8_SCHED; \
            if constexpr (P::STREAM != 0) { \
                if ((strip & 1u) == 0) { \
                    _Pragma("unroll") for (int j = 0; j < 4; ++j) sacc[j] = __builtin_amdgcn_cvt_pk_fp8_f32(se0[j] * 64.f, se1[j] * 64.f, sacc[j], false); \
                } else { \
                    _Pragma("unroll") for (int j = 0; j < 4; ++j) sacc[j] = __builtin_amdgcn_cvt_pk_fp8_f32(se0[j] * 64.f, se1[j] * 64.f, sacc[j], true); \
                    if (sval) { \
                        unsigned char* dp; int dld; \
                        if constexpr (P::STREAM == 1) { const int q = stI & 4095, e = q >> 7, r = q & 127, kt = r >> 2, pn = r & 3; dld = 4096; \
                            dp = p.sdst + ((size_t)e * 1024 + pn * 256 + (stI >= 4096 ? 8 : 0) + 16 * (scc >> 1) + 4 * (scc & 1)) * 4096 + kt * 128 + 4 * srq; } \
                        else if constexpr (P::STREAM == 2) { const int e = stI >> 7, r = stI & 127, ft = r >> 5, dt = r & 31; dld = 512; \
                            dp = p.sdst + ((size_t)e * 4096 + dt * 128 + 4 * scc) * 512 + ft * 128 + 4 * srq; } \
                        else { const int kt = stI >> 5, nn = stI & 31; dld = 4096; \
                            dp = p.sdst + ((size_t)nn * 128 + 4 * scc) * 4096 + kt * 128 + 4 * srq; } \
                        _Pragma("unroll") for (int j = 0; j < 4; ++j) *(int*)(dp + (size_t)j * dld) = sacc[j]; \
                    } \
                } \
                ++strip; \
            } } while (0)
        G8_TRIP(0, true);
        if constexpr (P::L2PF) asm volatile("" :: "v"(l2pf[0]));
        if constexpr (P::GATHER) { asm volatile("" : "+v"(nvA[0][0]), "+v"(nvA[0][1]), "+v"(nvA[1][0]), "+v"(nvA[1][1])); p.a_rows_fin(wid, nvA); }
        for (int tq = 2; tq < nt; tq += 2) G8_TRIP(tq, false);
#undef G8_TRIP
        if (wr == 0) G8_BAR;
        if constexpr (P::L2PF) p.l2_prefetch(has_next, cur, nxt, ui, wid, l2pf);
        asm volatile("s_nop 15\n\ts_nop 15" ::: "memory");
        { const int lz = lane_id_v(); p.epi(acc, cur, wid >> 2, wid & 3, lz & 15, lz >> 4, pre); }
        if (!has_next) break;
        cur = nxt; cA = nA; cB = nB; ++ui;
        if constexpr (P::GATHER) { cvA[0][0] = nvA[0][0]; cvA[0][1] = nvA[0][1]; cvA[1][0] = nvA[1][0]; cvA[1][1] = nvA[1][1]; }
        if (wr == 1) G8_BAR;
    }
    G8_WAIT_V(0);
    G8_BAR;
#undef G8_SA
#undef G8_SB
#undef G8_STAGE_A
#undef G8_STAGE_B
#undef G8_LDA
#undef G8_FA
#undef G8_FB
#undef G8_RD
#undef G8_WAIT_L_AB
#undef G8_WAIT_L_A
#undef G8_LDB
#undef G8_MMA
#undef G8_MMA0
#undef G8_MMAF
#undef G8_WAIT_V
#undef G8_WAIT_L
#undef G8_BAR
#undef G8_SCHED
}

template <int EPI  , bool F8 = false, int STRM = 0> struct DenseP {
    static constexpr bool GATHER = false, FP8 = F8; static constexpr int SCALE_B = 0x7f7f7f7f;
    static constexpr bool L2PF = false; __device__ __forceinline__ void l2_prefetch(bool, const Unit&, const Unit&, int, int, int (&)[1]) const {}
    static constexpr int NPF = 0, NS = (EPI == 0 ? 16 : EPI == 1 ? 24 : 44);
    static constexpr int STREAM = STRM;
    const float* ssrc0; const float* ssrc1; unsigned char* sdst; int sbid, sk1; int pad2_[2];
    const char* A; const char* B; bf16_t* C; unsigned char* C8;
    unsigned lda2, ldb2; int nt, nM, nN, G, c, mPer, bDiv, ldc; float oscale; int direct;
    size_t aHi, aLo, bHi, bLo, cHi, cLo;
    const float* rowscale; const float* resid; const bf16_t* residb;
    __device__ __forceinline__ bool next(int i, Unit& u) const { u.e = 0; u.mt = 0; u.cnt = 0; u.rb = 0;
        if (direct) { u.pm = c; u.pn = i; return i < nN; }
        return static_tile(i, G, c, nM, nN, u.pm, u.pn); }
    __device__ __forceinline__ unsigned a_off(const Unit& u) const { const int batch = u.pm / mPer, mt = u.pm % mPer; return (unsigned)((size_t)(batch / bDiv) * aHi + (size_t)(batch % bDiv) * aLo + (size_t)mt * 256 * lda2); }
    __device__ __forceinline__ unsigned b_off(const Unit& u) const { const int batch = u.pm / mPer; return (unsigned)((size_t)(batch / bDiv) * bHi + (size_t)(batch % bDiv) * bLo + (size_t)u.pn * 256 * ldb2); }
    struct Pre {};
    __device__ __forceinline__ void prefetch(const Unit&, int, Pre&) const {}
    __device__ __forceinline__ void a_rows(const Unit&, int, unsigned (&)[2][2]) const {}
    __device__ __forceinline__ void a_rows_fin(int, unsigned (&)[2][2]) const {}
    __device__ __forceinline__ void epi(const Acc& acc, const Unit& u, int wr, int wc, int fr, int fq, const Pre&) const {
        const int batch = u.pm / mPer, mt = u.pm % mPer;
        const int row0 = mt * 256 + wr * 64 + fr, col0 = u.pn * 256 + wc * 64 + 16 * fq;
        bf16_t* base = C + (size_t)(batch / bDiv) * cHi + (size_t)(batch % bDiv) * cLo;
        float rsv[2][4];
#pragma unroll
        for (int ai = 0; ai < 2; ++ai)
#pragma unroll
            for (int m = 0; m < 4; ++m) rsv[ai][m] = (EPI == 1) ? rowscale[row0 + ai * 128 + m * 16] : 1.f;
        if constexpr (EPI == 2) {
            f32x4 cs8[2][2];
#pragma unroll
            for (int bj = 0; bj < 2; ++bj) { cs8[bj][0] = *(const f32x4*)(rowscale + col0 + bj * 8); cs8[bj][1] = *(const f32x4*)(rowscale + col0 + bj * 8 + 4); }
#pragma unroll
            for (int ai = 0; ai < 2; ++ai) {
                u32x4 rv[4][2];
#pragma unroll
                for (int m = 0; m < 4; ++m)
#pragma unroll
                    for (int bj = 0; bj < 2; ++bj) rv[m][bj] = *(const u32x4*)(residb + (size_t)(row0 + ai * 128 + m * 16) * ldc + col0 + bj * 8);
                __builtin_amdgcn_sched_barrier(0);
#pragma unroll
                for (int m = 0; m < 4; ++m) {
                    const int row = row0 + ai * 128 + m * 16;
                    u32x2 f8[2];
#pragma unroll
                    for (int bj = 0; bj < 2; ++bj) {
                        const u32x4 rw = rv[m][bj];
                        const f32x4 v0 = acc[ai][bj][m][0] * oscale + (f32x4){bf_lo(rw.x), bf_hi(rw.x), bf_lo(rw.y), bf_hi(rw.y)}, v1 = acc[ai][bj][m][1] * oscale + (f32x4){bf_lo(rw.z), bf_hi(rw.z), bf_lo(rw.w), bf_hi(rw.w)};
                        *(u32x4*)(base + (size_t)row * ldc + col0 + bj * 8) = pack8(v0, v1);
                        f8[bj] = pack8_fp8(v0 * cs8[bj][0], v1 * cs8[bj][1]);
                    }
                    *(u32x4*)(C8 + (size_t)row * ldc + col0) = (u32x4){f8[0].x, f8[0].y, f8[1].x, f8[1].y};
                }
                __builtin_amdgcn_sched_barrier(0);
            }
        } else {
#pragma unroll
        for (int ai = 0; ai < 2; ++ai)
#pragma unroll
            for (int m = 0; m < 4; ++m) {
                const int row = row0 + ai * 128 + m * 16;
                const float rs = rsv[ai][m];
#pragma unroll
                for (int bj = 0; bj < 2; ++bj) {
                    f32x4 v0 = acc[ai][bj][m][0], v1 = acc[ai][bj][m][1];
                    if (EPI == 1) { v0 *= rs; v1 *= rs; }
                    *(u32x4*)(base + (size_t)row * ldc + col0 + bj * 8) = pack8(v0, v1);
                }
            }
        }
    }
};

#define TABU(x) __builtin_amdgcn_readfirstlane(x)
__device__ __forceinline__ void moe_rec(const int* tab, Unit& u) {
    const i32x4 r = *(const i32x4*)(tab + 4 + 4 * u.pm);
    u.e = TABU(r.x); u.mt = TABU(r.y); u.cnt = TABU(r.z); u.rb = TABU(r.w); }
struct MoeGateUpP {
    static constexpr bool GATHER = true, FP8 = true; static constexpr int SCALE_B = 0x7f7f7f7f, STREAM = 0, NPF = 12  , NS = 12  ;
    static constexpr bool L2PF = false; __device__ __forceinline__ void l2_prefetch(bool, const Unit&, const Unit&, int, int, int (&)[1]) const {}
    const char* A; const char* B; unsigned lda2, ldb2; int nt, G, c;
    const int* tab; int m0, nMv;
    const int* rowtok; const float* rowrstd; const float* bgate; const float* bup; unsigned char* act;
    i32x4 lrec; int lpp;
    __device__ __forceinline__ bool unit_tile(int i, int& pm, int& pn) const { if (!static_tile(i, G, c, nMv, 4, pm, pn)) return false; pm += m0; return true; }
    __device__ __forceinline__ void preload() { const int lz = lane_id_v(); int pm, pn; lrec = (i32x4){0, 0, 0, 0}; lpp = -1;
        if (unit_tile(lz, pm, pn)) { lrec = *(const i32x4*)(tab + 4 + 4 * pm); lpp = pm | (pn << 16); } }
    __device__ __forceinline__ bool next(int i, Unit& u) const {
        if (i < 64) { const int pp = __builtin_amdgcn_readlane(lpp, i); if (pp < 0) return false; u.pm = pp & 0xffff; u.pn = pp >> 16;
            u.e = __builtin_amdgcn_readlane(lrec.x, i); u.mt = __builtin_amdgcn_readlane(lrec.y, i); u.cnt = __builtin_amdgcn_readlane(lrec.z, i); u.rb = __builtin_amdgcn_readlane(lrec.w, i); return true; }
        if (!unit_tile(i, u.pm, u.pn)) return false; moe_rec(tab, u); return true; }
    __device__ __forceinline__ unsigned a_off(const Unit&) const { return 0u; }
    __device__ __forceinline__ unsigned b_off(const Unit& u) const { return (unsigned)(((size_t)u.e * 1024 + (size_t)u.pn * 256) * ldb2); }
    __device__ __forceinline__ void a_rows(const Unit& u, int wid, unsigned (&v)[2][2]) const {
        const int cnt = u.cnt;
        const int tz = wid * 64 + lane_id_v(); int Rr[2], Cc[2]; stage_rc(tz * 16, Rr[0], Cc[0]); stage_rc(tz * 16 + 8192, Rr[1], Cc[1]);
#pragma unroll
        for (int h = 0; h < 2; ++h)
#pragma unroll
            for (int i = 0; i < 2; ++i) { const int pos = min(u.mt * 256 + h * 128 + Rr[i], cnt - 1); v[h][i] = (unsigned)rowtok[u.e * CAP + pos]; }
    }
    __device__ __forceinline__ void a_rows_fin(int wid, unsigned (&v)[2][2]) const {
        const int tz = wid * 64 + lane_id_v(); int Rr[2], Cc[2]; stage_rc(tz * 16, Rr[0], Cc[0]); stage_rc(tz * 16 + 8192, Rr[1], Cc[1]);
#pragma unroll
        for (int h = 0; h < 2; ++h)
#pragma unroll
            for (int i = 0; i < 2; ++i) v[h][i] = v[h][i] * lda2 + (unsigned)Cc[i] * 2u;
    }
    struct Pre { float rs[2][4]; };
    __device__ __forceinline__ void prefetch(const Unit& u, int wid, Pre& q) const {
        const int lz = lane_id_v(), wr = wid >> 2, fr = lz & 15;
#pragma unroll
        for (int ai = 0; ai < 2; ++ai)
#pragma unroll
            for (int m = 0; m < 4; ++m) { const int pos = min(u.mt * 256 + ai * 128 + wr * 64 + m * 16 + fr, u.cnt - 1); q.rs[ai][m] = rowrstd[u.e * CAP + pos]; }
    }
    __device__ __forceinline__ void epi(const Acc& acc, const Unit& u, int wr, int wc, int fr, int fq, const Pre& q) const {
        const int cnt = u.cnt, rb = u.rb;
        const int f0 = u.pn * 128 + wc * 32 + 8 * fq;
        const f32x4 bg0 = *(const f32x4*)(bgate + u.e * DFF + f0), bg1 = *(const f32x4*)(bgate + u.e * DFF + f0 + 4);
        const f32x4 bu0 = *(const f32x4*)(bup + u.e * DFF + f0), bu1 = *(const f32x4*)(bup + u.e * DFF + f0 + 4);
        float rsv[2][4];
#pragma unroll
        for (int ai = 0; ai < 2; ++ai)
#pragma unroll
            for (int m = 0; m < 4; ++m) rsv[ai][m] = q.rs[ai][m] * (1.0f / 64.0f);
        asm volatile("" :: "v"(rsv[0][0]), "v"(rsv[0][1]), "v"(rsv[0][2]), "v"(rsv[0][3]), "v"(rsv[1][0]), "v"(rsv[1][1]), "v"(rsv[1][2]), "v"(rsv[1][3]), "v"(bg0), "v"(bg1), "v"(bu0), "v"(bu1));
#pragma unroll
        for (int ai = 0; ai < 2; ++ai)
#pragma unroll
            for (int m = 0; m < 4; ++m) {
                const int pos = u.mt * 256 + ai * 128 + wr * 64 + m * 16 + fr;
                {
                    const float rs = rsv[ai][m];
                    f32x4 o[2];
#pragma unroll
                    for (int n = 0; n < 2; ++n) {
                        const f32x4 g = acc[ai][0][m][n] * rs + (n ? bg1 : bg0), up = acc[ai][1][m][n] * rs + (n ? bu1 : bu0);
#pragma unroll
                        for (int j = 0; j < 4; ++j) {
                            const float hg = fminf(g[j], 7.0f), hu = fminf(fmaxf(up[j], -7.0f), 7.0f);
                            const float sg = __builtin_amdgcn_rcpf(1.0f + __builtin_amdgcn_exp2f(-1.702f * 1.44269504f * hg));
                            o[n][j] = hg * sg * (hu + 1.0f);
                        }
                    }
                    *(u32x2*)(act + (size_t)(pos < cnt ? rb + pos : NTOK * 4) * DFF + f0) = pack8_fp8(o[0], o[1]);
                }
            }
    }
};
struct MoeDownP {
    static constexpr bool GATHER = false, FP8 = true; static constexpr int SCALE_B = 0x7f7f7f7f, STREAM = 0, NPF = 20  , NS = 9  ;
    static constexpr bool L2PF = true;
    const char* A; const char* B; unsigned lda2, ldb2; int nt, G, c;
    const int* tab; int mode, nbusy, m0, nMv;
    const int* rowdst; const float* rowgate; const float* bdown; unsigned char* y;
    i32x4 lrec; int lpp;
    __device__ __forceinline__ bool unit_tile(int i, int& pm, int& pn) const {
        if (mode == 1) { if (!static_tile(i, G, c, nMv, 16, pm, pn)) return false; pm += m0; }
        else { const int nfree = G - nbusy; long idx;
            if (c >= nbusy) idx = (i < 4) ? (long)i * nfree + (c - nbusy) : 4l * nfree + (long)(i - 4) * G + c;
            else idx = 4l * nfree + (long)i * G + c;
            if (!tile_of_L(idx, nMv, 16, pm, pn)) return false; }
        return true; }
    __device__ __forceinline__ void preload() { const int lz = lane_id_v(); int pm, pn; lrec = (i32x4){0, 0, 0, 0}; lpp = -1;
        if (unit_tile(lz, pm, pn)) { lrec = *(const i32x4*)(tab + 4 + 4 * pm); lpp = pm | (pn << 16); } }
    __device__ __forceinline__ bool next(int i, Unit& u) const {
        if (i < 64) { const int pp = __builtin_amdgcn_readlane(lpp, i); if (pp < 0) return false; u.pm = pp & 0xffff; u.pn = pp >> 16;
            u.e = __builtin_amdgcn_readlane(lrec.x, i); u.mt = __builtin_amdgcn_readlane(lrec.y, i); u.cnt = __builtin_amdgcn_readlane(lrec.z, i); u.rb = __builtin_amdgcn_readlane(lrec.w, i); return true; }
        if (!unit_tile(i, u.pm, u.pn)) return false; moe_rec(tab, u); return true; }
    __device__ __forceinline__ unsigned a_off(const Unit& u) const { return (unsigned)((size_t)(u.rb + u.mt * 256) * lda2); }
    __device__ __forceinline__ void l2_prefetch(bool has_next, const Unit& cur, const Unit& nxt, int, int wid, int (&v)[1]) const {
        const int e1 = has_next ? nxt.e : cur.e, pn1 = has_next ? nxt.pn : cur.pn;
        const int tz = wid * 64 + lane_id_v(); const unsigned ro = (unsigned)(tz >> 1) * 512u + (unsigned)(tz & 1) * 128u + 256u;
        const char* b1 = B + ((size_t)((size_t)e1 * 4096 + (size_t)pn1 * 256) * ldb2 + ro);
        asm volatile("global_load_dword %0, %1, off" : "=v"(v[0]) : "v"(b1) : "memory");
    }
    __device__ __forceinline__ unsigned b_off(const Unit& u) const { return (unsigned)(((size_t)u.e * 4096 + (size_t)u.pn * 256) * ldb2); }
    __device__ __forceinline__ void a_rows(const Unit&, int, unsigned (&)[2][2]) const {}
    __device__ __forceinline__ void a_rows_fin(int, unsigned (&)[2][2]) const {}
    struct Pre { float gw[2][4]; int ds[2][4]; f32x4 bd[2][2]; };
    __device__ __forceinline__ void prefetch(const Unit& u, int wid, Pre& q) const {
        const int lz = lane_id_v(), wr = wid >> 2, fr = lz & 15;
        {   const int c0 = u.pn * 256 + (wid & 3) * 64 + 16 * (lz >> 4);
#pragma unroll
            for (int bj = 0; bj < 2; ++bj) { q.bd[bj][0] = *(const f32x4*)(bdown + (size_t)u.e * DM + c0 + bj * 8); q.bd[bj][1] = *(const f32x4*)(bdown + (size_t)u.e * DM + c0 + bj * 8 + 4); } }
#pragma unroll
        for (int ai = 0; ai < 2; ++ai)
#pragma unroll
            for (int m = 0; m < 4; ++m) { const int pos = min(u.mt * 256 + ai * 128 + wr * 64 + m * 16 + fr, u.cnt - 1); q.gw[ai][m] = rowgate[u.e * CAP + pos]; q.ds[ai][m] = rowdst[u.e * CAP + pos]; }
    }
    __device__ __forceinline__ void epi(const Acc& acc, const Unit& u, int wr, int wc, int fr, int fq, const Pre& q) const {
        const int cnt = u.cnt;
        const int c0 = u.pn * 256 + wc * 64 + 16 * fq;
        f32x4 bd[2][2];
#pragma unroll
        for (int bj = 0; bj < 2; ++bj) { bd[bj][0] = q.bd[bj][0]; bd[bj][1] = q.bd[bj][1]; }
        asm volatile("" :: "v"(bd[0][0]), "v"(bd[0][1]), "v"(bd[1][0]), "v"(bd[1][1]));
        float gwv[2][4]; int dsv[2][4];
#pragma unroll
        for (int ai = 0; ai < 2; ++ai)
#pragma unroll
            for (int m = 0; m < 4; ++m) { gwv[ai][m] = q.gw[ai][m] * 8.0f; dsv[ai][m] = q.ds[ai][m]; }
        asm volatile("" :: "v"(gwv[0][0]), "v"(gwv[0][1]), "v"(gwv[0][2]), "v"(gwv[0][3]), "v"(gwv[1][0]), "v"(gwv[1][1]), "v"(gwv[1][2]), "v"(gwv[1][3]), "v"(dsv[0][0]), "v"(dsv[0][1]), "v"(dsv[0][2]), "v"(dsv[0][3]), "v"(dsv[1][0]), "v"(dsv[1][1]), "v"(dsv[1][2]), "v"(dsv[1][3]), "v"(bd[0][0]), "v"(bd[0][1]), "v"(bd[1][0]), "v"(bd[1][1]));
#pragma unroll
        for (int ai = 0; ai < 2; ++ai)
#pragma unroll
            for (int m = 0; m < 4; ++m) {
                const int pos = u.mt * 256 + ai * 128 + wr * 64 + m * 16 + fr;
                {
                    const float gw = gwv[ai][m]; const int dst = pos < cnt ? dsv[ai][m] : NTOK * 4;
                    u32x2 f8[2];
#pragma unroll
                    for (int bj = 0; bj < 2; ++bj) {
                        const f32x4 v0 = (acc[ai][bj][m][0] * (1.0f / 64.0f) + bd[bj][0]) * gw, v1 = (acc[ai][bj][m][1] * (1.0f / 64.0f) + bd[bj][1]) * gw;
                        f8[bj] = pack8_fp8(v0, v1);
                    }
                    *(u32x4*)(y + (size_t)dst * DM + c0) = (u32x4){f8[0].x, f8[0].y, f8[1].x, f8[1].y};
                }
            }
    }
};
}

struct Params { const float* in[17]; float* out; unsigned char* ws; int ph_lo, ph_hi; };
enum { I_X = 0, I_G1, I_WIN, I_POOLW, I_POOLS, I_FW, I_WOUT, I_G2, I_RW, I_RB, I_WG, I_BG, I_WU, I_BU, I_WD, I_BD, I_GF };

struct Ctx { const Params* p; LAS unsigned char* lds; int tid, lane, wave, G, bid; };

struct TileD { const float* src; bf16_t* dst; const float* rs; const float* cs; int lds_, ldd; float mul; int perm; };
constexpr int NT_WINF = 512, NT_WOUT = 1024, NT_EXP = 4096, NT_SMALL = 64;
constexpr int T0_WOUT = NT_WINF, T0_PW = T0_WOUT, T0_FW = T0_PW + NT_SMALL, NT_BF = T0_FW + NT_SMALL;
constexpr int T8_WU = NT_EXP, T8_WD = 2 * NT_EXP, NT_F8 = 3 * NT_EXP, T8_WOUT_END = NT_F8 + NT_WOUT;
__device__ __forceinline__ TileD tile_desc(const Params& p, int t) {
    TileD d; d.rs = nullptr; d.cs = nullptr; d.mul = 1.f; d.perm = 0;
    unsigned char* ws = p.ws;
    if (t < T0_WOUT) { const int kt = t / 16, n = t % 16;
        d.src = p.in[I_WIN] + (size_t)kt * 128 * 4096 + 2048 + n * 128; d.lds_ = 4096; d.dst = (bf16_t*)(ws + E_WINT) + (size_t)(2048 + n * 128) * 4096 + kt * 128; d.ldd = 4096; d.rs = p.in[I_G1] + kt * 128;
    } else if (t < T0_FW) { const int q = t - T0_PW, g = q / 16, r = q % 16, jt = r / 4, n = r % 4;
        d.src = p.in[I_POOLW] + (size_t)g * 512 * 512 + (size_t)jt * 128 * 512 + n * 128; d.lds_ = 512; d.dst = (bf16_t*)(ws + WS_PWT) + (size_t)g * 512 * 512 + (size_t)(n * 128) * 512 + jt * 128; d.ldd = 512; d.cs = p.in[I_POOLS] + g * 512 + n * 128;
    } else { const int q = t - T0_FW, g = q / 16, r = q % 16, jt = r / 4, n = r % 4;
        d.src = p.in[I_FW] + (size_t)g * 512 * 512 + (size_t)jt * 128 * 512 + n * 128; d.lds_ = 512; d.dst = (bf16_t*)(ws + WS_FWT) + (size_t)g * 512 * 512 + (size_t)(n * 128) * 512 + jt * 128; d.ldd = 512;
    }
    return d;
}
__device__ __forceinline__ TileD tile_desc8(const Params& p, int t) {
    TileD d; d.rs = nullptr; d.cs = nullptr; d.mul = 64.f; d.perm = 0;
    unsigned char* ws = p.ws;
    if (t < T8_WD) { const bool up = t >= T8_WU; const int q = t - (up ? T8_WU : 0), e = q / 128, r = q % 128, kt = r / 4, pn = r % 4;
        d.src = p.in[up ? I_WU : I_WG] + (size_t)e * 4096 * 512 + (size_t)kt * 128 * 512 + pn * 128; d.lds_ = 512;
        d.dst = (bf16_t*)(ws + WS_WGU + ((size_t)e * 1024 + pn * 256 + (up ? 8 : 0)) * 4096 + kt * 128); d.ldd = 4096; d.perm = 1;
    } else if (t < NT_F8) { const int q = t - T8_WD, e = q / 128, r = q % 128, ft = r / 32, dt = r % 32;
        d.src = p.in[I_WD] + (size_t)e * 512 * 4096 + (size_t)ft * 128 * 4096 + dt * 128; d.lds_ = 4096; d.dst = (bf16_t*)(ws + WS_WD + ((size_t)e * 4096 + dt * 128) * 512 + ft * 128); d.ldd = 512;
    } else { const int q = t - NT_F8, kt = q / 32, nn = q % 32;
        d.src = p.in[I_WOUT] + (size_t)kt * 128 * 4096 + nn * 128; d.lds_ = 4096; d.dst = (bf16_t*)(ws + E_WOUTT + (size_t)(nn * 128) * 4096 + kt * 128); d.ldd = 4096;
    }
    return d;
}
constexpr int TP8_PITCH = 144;
__device__ __forceinline__ void tile8_load(const TileD& d, int wave, int lane, f32x4 (&v)[2][4], float (&rs)[2][4]) {
#pragma unroll
    for (int i = 0; i < 2; ++i) { const int bi = wave * 2 + i, rq = (bi >> 2) * 8 + (lane >> 3), cc = (bi & 3) * 8 + (lane & 7);
        const float* s = d.src + (size_t)(4 * rq) * d.lds_ + cc * 4;
#pragma unroll
        for (int r = 0; r < 4; ++r) { v[i][r] = __builtin_nontemporal_load((const f32x4*)(s + (size_t)r * d.lds_)); rs[i][r] = (d.rs ? d.rs[4 * rq + r] : 1.f) * d.mul; } }
}
__device__ __forceinline__ void tile8_to_lds(LAS unsigned char* tl, int wave, int lane, const f32x4 (&v)[2][4], const float (&rs)[2][4]) {
#pragma unroll
    for (int i = 0; i < 2; ++i) { const int bi = wave * 2 + i, rq = (bi >> 2) * 8 + (lane >> 3), cc = (bi & 3) * 8 + (lane & 7);
#pragma unroll
        for (int j = 0; j < 4; ++j) { int w = 0; w = __builtin_amdgcn_cvt_pk_fp8_f32(v[i][0][j] * rs[i][0], v[i][1][j] * rs[i][1], w, false); w = __builtin_amdgcn_cvt_pk_fp8_f32(v[i][2][j] * rs[i][2], v[i][3][j] * rs[i][3], w, true);
            *(LAS int*)(tl + (cc * 4 + j) * TP8_PITCH + rq * 4) = w; } }
}
__device__ __forceinline__ void tile8_store(const TileD& d, const LAS unsigned char* tl, int tid) {
#pragma unroll
    for (int i = 0; i < 2; ++i) { const int q = tid + 512 * i, c = q >> 3, ch = q & 7;
        const u32x4 w = *(const LAS u32x4*)(tl + c * TP8_PITCH + ch * 16);
        const int cr = d.perm ? ((c >> 3) * 16 + (c & 7)) : c;
        __builtin_nontemporal_store(w, (u32x4*)((unsigned char*)d.dst + (size_t)cr * d.ldd + ch * 16)); }
}
constexpr int TP_PITCH = 272;
__device__ __forceinline__ void tile_load(const TileD& d, int wave, int lane, f32x4 (&v)[4][2], float (&rs)[4][2], f32x4 (&cs)[4]) {
#pragma unroll
    for (int i = 0; i < 4; ++i) { const int bi = wave * 4 + i, rp = (bi >> 2) * 8 + (lane >> 3), cc = (bi & 3) * 8 + (lane & 7);
        const float* s = d.src + (size_t)(2 * rp) * d.lds_ + cc * 4;
        v[i][0] = __builtin_nontemporal_load((const f32x4*)s); v[i][1] = __builtin_nontemporal_load((const f32x4*)(s + d.lds_));
        rs[i][0] = d.rs ? d.rs[2 * rp] : 1.f; rs[i][1] = d.rs ? d.rs[2 * rp + 1] : 1.f;
        cs[i] = d.cs ? *(const f32x4*)(d.cs + cc * 4) : (f32x4){1.f, 1.f, 1.f, 1.f}; }
}
__device__ __forceinline__ void tile_to_lds(LAS unsigned char* tl, int wave, int lane, const f32x4 (&v)[4][2], const float (&rs)[4][2], const f32x4 (&cs)[4]) {
#pragma unroll
    for (int i = 0; i < 4; ++i) { const int bi = wave * 4 + i, rp = (bi >> 2) * 8 + (lane >> 3), cc = (bi & 3) * 8 + (lane & 7);
#pragma unroll
        for (int j = 0; j < 4; ++j) *(LAS unsigned*)(tl + (cc * 4 + j) * TP_PITCH + rp * 4) = cvt_pk_bf16(v[i][0][j] * rs[i][0] * cs[i][j], v[i][1][j] * rs[i][1] * cs[i][j]); }
}
__device__ __forceinline__ void tile_store(const TileD& d, const LAS unsigned char* tl, int tid) {
#pragma unroll
    for (int i = 0; i < 4; ++i) { const int q = tid + 512 * i, c = q >> 4, ch = q & 15;
        const u32x4 w = *(const LAS u32x4*)(tl + c * TP_PITCH + ch * 16);
        *(u32x4*)(d.dst + (size_t)c * d.ldd + ch * 8) = w; }
}
__device__ __forceinline__ void convert_tiles8(const Ctx& X, const int tb, const int te, const int k0, const int k1) {
    const Params& p = *X.p;
    f32x4 vA[2][4], vB[2][4]; float rA[2][4], rB[2][4];
    const int step = 2 * X.G;
    int t0 = tb + X.bid + k0 * X.G, t1 = t0 + X.G;
    const long tlim = (long)tb + X.bid + (long)k1 * X.G; const int tend = (int)(tlim < te ? tlim : te);
    TileD dA, dB;
    if (t0 < tend) { dA = tile_desc8(p, t0); tile8_load(dA, X.wave, X.lane, vA, rA); }
    if (t1 < tend) { dB = tile_desc8(p, t1); tile8_load(dB, X.wave, X.lane, vB, rB); }
    LAS unsigned char* tl0 = X.lds; LAS unsigned char* tl1 = X.lds + 128 * TP8_PITCH;
    while (t0 < tend) {
        tile8_to_lds(tl0, X.wave, X.lane, vA, rA);
        const TileD d0 = dA; if (t0 + step < tend) { dA = tile_desc8(p, t0 + step); tile8_load(dA, X.wave, X.lane, vA, rA); }
        __syncthreads();
        tile8_store(d0, tl0, X.tid);
        if (t1 < tend) {
            tile8_to_lds(tl1, X.wave, X.lane, vB, rB);
            const TileD d1 = dB; if (t1 + step < tend) { dB = tile_desc8(p, t1 + step); tile8_load(dB, X.wave, X.lane, vB, rB); }
            __syncthreads();
            tile8_store(d1, tl1, X.tid);
        }
        t0 += step; t1 += step;
    }
    __syncthreads();
}
__device__ __forceinline__ void p0_prep(const Ctx& X) {
    const Params& p = *X.p; unsigned char* ws = p.ws;
    const int gw = X.bid * 8 + X.wave, NGW = X.G * 8, gt = X.bid * NTHREADS + X.tid, NGT = X.G * NTHREADS;
    {   const float* x = p.in[I_X]; bf16_t* xb = (bf16_t*)(ws + E_XB); float* rstd = (float*)(ws + WS_RSTD1);
        for (int r = gw; r < NTOK; r += NGW) {
            const float* xr = x + (size_t)r * DM; f32x4 v[8][2]; float ss = 0.f;
#pragma unroll
            for (int i = 0; i < 8; ++i) { const int c = (i * 64 + X.lane) * 8; v[i][0] = __builtin_nontemporal_load((const f32x4*)(xr + c)); v[i][1] = __builtin_nontemporal_load((const f32x4*)(xr + c + 4)); }
#pragma unroll
            for (int i = 0; i < 8; ++i) {
#pragma unroll
                for (int j = 0; j < 4; ++j) ss += v[i][0][j] * v[i][0][j] + v[i][1][j] * v[i][1][j];
                *(u32x4*)(xb + (size_t)r * DM + (i * 64 + X.lane) * 8) = pack8(v[i][0], v[i][1]); }
            ss = wave_sum(ss);
            if (X.lane == 0) rstd[r] = rsqrtf(ss * (1.0f / DM) + RMS_EPS);
        }
    }
    {   f32x4 vA[4][2], vB[4][2]; float rA[4][2], rB[4][2]; f32x4 cA[4], cB[4];
        int t0 = X.bid, t1 = X.bid + X.G; const int step = 2 * X.G;
        TileD dA, dB;
        if (t0 < NT_BF) { dA = tile_desc(p, t0); tile_load(dA, X.wave, X.lane, vA, rA, cA); }
        if (t1 < NT_BF) { dB = tile_desc(p, t1); tile_load(dB, X.wave, X.lane, vB, rB, cB); }
        LAS unsigned char* tl0 = X.lds; LAS unsigned char* tl1 = X.lds + 128 * TP_PITCH;
        while (t0 < NT_BF) {
            tile_to_lds(tl0, X.wave, X.lane, vA, rA, cA);
            const TileD d0 = dA; if (t0 + step < NT_BF) { dA = tile_desc(p, t0 + step); tile_load(dA, X.wave, X.lane, vA, rA, cA); }
            __syncthreads();
            tile_store(d0, tl0, X.tid);
            if (t1 < NT_BF) {
                tile_to_lds(tl1, X.wave, X.lane, vB, rB, cB);
                const TileD d1 = dB; if (t1 + step < NT_BF) { dB = tile_desc(p, t1 + step); tile_load(dB, X.wave, X.lane, vB, rB, cB); }
                __syncthreads();
                tile_store(d1, tl1, X.tid);
            }
            t0 += step; t1 += step;
        }
        __syncthreads();
    }
    {   const float* w = p.in[I_WIN]; const float* g1 = p.in[I_G1]; bf16_t* o = (bf16_t*)(ws + E_WINP);
        for (int it = gt; it < 4096 * 256; it += NGT) { const int k = it >> 8, j = (it & 255) * 8; const float g = g1[k];
            const f32x4 a = __builtin_nontemporal_load((const f32x4*)(w + (size_t)k * 4096 + j)) * g, b = __builtin_nontemporal_load((const f32x4*)(w + (size_t)k * 4096 + j + 4)) * g;
            *(u32x4*)(o + (size_t)k * 2048 + j) = pack8(a, b); }
    }
    {   bf16_t* o = (bf16_t*)(ws + WS_DFTC);
        for (int it = gt; it < 1024 * 64; it += NGT) { const int n = it >> 6, i0 = (it & 63) * 8; float f[8];
#pragma unroll
            for (int j = 0; j < 8; ++j) { const int m = ((n & 511) * (i0 + j)) & 511; float s, c; sincospif((float)m * (1.0f / 256.0f), &s, &c); f[j] = (n < 512) ? c : s; }
            u32x4 w; w.x = cvt_pk_bf16(f[0], f[1]); w.y = cvt_pk_bf16(f[2], f[3]); w.z = cvt_pk_bf16(f[4], f[5]); w.w = cvt_pk_bf16(f[6], f[7]);
            *(u32x4*)(o + (size_t)n * 512 + i0) = w; }
    }
    {   const float* rw = p.in[I_RW]; const float* g2 = p.in[I_G2]; bf16_t* o = (bf16_t*)(ws + WS_RWT);
        for (int it = gt; it < 32 * 4096; it += NGT) { const int e = it >> 12, k = it & 4095; const float v = g2[k] * rw[k * 32 + e];
            const unsigned hi = cvt_pk_bf16(v, 0.f) & 0xffffu; const float lo = v - __uint_as_float(hi << 16);
            o[(size_t)e * 4096 + k] = (bf16_t)hi; o[(size_t)(32 + e) * 4096 + k] = (bf16_t)(cvt_pk_bf16(lo, 0.f) & 0xffffu); }
    }
}

__device__ __forceinline__ void p3_mix_prep(const Ctx& X, const bool tilewise) {
    const Params& p = *X.p; unsigned char* ws = p.ws;
    const bf16_t* u = (const bf16_t*)(ws + E_U); unsigned char* mixed = ws + E_MIXED;
    const int gt = X.bid * NTHREADS + X.tid, NGT = X.G * NTHREADS;
    constexpr int PP = 528;
    {   u32x4 ld[5];
        bf16_t* vv = (bf16_t*)(ws + E_VEVO);
        auto issue = [&](int w) { const int b = w >> 9, rem = w & 511, tt = rem >> 3, gc = rem & 7, g = gc >> 1, ch0 = g * 512 + (gc & 1) * 256, t0 = tt * 64;
#pragma unroll
            for (int i = 0; i < 5; ++i) { const int q = X.tid + 512 * i, rr = q >> 5, cq = q & 31, t = min(max(t0 - 8 + rr, 0), SEQ - 1);
                ld[i] = __builtin_nontemporal_load((const u32x4*)(u + (size_t)(b * SEQ + t) * DM + ch0 + cq * 8)); } };
        const int NGV = tilewise ? NTHREADS : NGT, itEnd = tilewise ? 256 * 64 : NTOK * 256;
        int w = X.bid; int it0 = tilewise ? X.tid : gt;
        if (w < 2048) issue(w);
        while (w < 2048 || it0 < itEnd) {
            const bool dov = it0 < itEnd, dop = w < 2048;
            u32x4 va[4], vr[4];
            if (dov) {
#pragma unroll
                for (int k = 0; k < 4; ++k) { const int it = it0 + k * NGV, tok = tilewise ? (X.bid & 63) * 256 + (it >> 6) : it >> 8, q = tilewise ? (X.bid >> 6) * 64 + (it & 63) : it & 255, b = tok >> 12, sq = tok & 4095, rs = (SEQ - sq) & (SEQ - 1);
                    va[k] = *(const u32x4*)(u + (size_t)tok * DM + 2048 + q * 8); vr[k] = *(const u32x4*)(u + (size_t)(b * SEQ + rs) * DM + 2048 + q * 8); } }
            if (dop) {
                const int b = w >> 9, rem = w & 511, tt = rem >> 3, gc = rem & 7, g = gc >> 1, ch0 = g * 512 + (gc & 1) * 256;
                const int t0 = tt * 64, hw = 1 << g;
#pragma unroll
                for (int i = 0; i < 5; ++i) { const int q = X.tid + 512 * i, rr = q >> 5, cq = q & 31; if (rr < 79) *(LAS u32x4*)(X.lds + rr * PP + cq * 16) = ld[i]; }
                __syncthreads();
                if (w + X.G < 2048) issue(w + X.G);
                {
                    const int cq = X.tid & 31, tl0 = (X.tid >> 5) * 4;
                    float sm[8] = {0.f, 0.f, 0.f, 0.f, 0.f, 0.f, 0.f, 0.f};
                    {   const int t = t0 + tl0, lo = max(t - hw, 0), hi = min(t + hw - 1, SEQ - 1);
                        for (int r = lo; r <= hi; ++r) { const u32x4 v = *(const LAS u32x4*)(X.lds + (r - t0 + 8) * PP + cq * 16);
                            sm[0] += bf_lo(v.x); sm[1] += bf_hi(v.x); sm[2] += bf_lo(v.y); sm[3] += bf_hi(v.y); sm[4] += bf_lo(v.z); sm[5] += bf_hi(v.z); sm[6] += bf_lo(v.w); sm[7] += bf_hi(v.w); } }
#pragma unroll
                    for (int j = 0; j < 4; ++j) { const int tl = tl0 + j, t = t0 + tl;
                        if (j > 0) {
                            const int re = t - 1 + hw, rl = t - 1 - hw;
                            if (re <= SEQ - 1) { const u32x4 v = *(const LAS u32x4*)(X.lds + (re - t0 + 8) * PP + cq * 16);
                                sm[0] += bf_lo(v.x); sm[1] += bf_hi(v.x); sm[2] += bf_lo(v.y); sm[3] += bf_hi(v.y); sm[4] += bf_lo(v.z); sm[5] += bf_hi(v.z); sm[6] += bf_lo(v.w); sm[7] += bf_hi(v.w); }
                            if (rl >= 0) { const u32x4 v = *(const LAS u32x4*)(X.lds + (rl - t0 + 8) * PP + cq * 16);
                                sm[0] -= bf_lo(v.x); sm[1] -= bf_hi(v.x); sm[2] -= bf_lo(v.y); sm[3] -= bf_hi(v.y); sm[4] -= bf_lo(v.z); sm[5] -= bf_hi(v.z); sm[6] -= bf_lo(v.w); sm[7] -= bf_hi(v.w); } }
                        const int lo = max(t - hw, 0), hi = min(t + hw - 1, SEQ - 1);
                        const u32x4 cv = *(const LAS u32x4*)(X.lds + (tl + 8) * PP + cq * 16);
                        const float inv = 1.0f / (float)(hi - lo + 1);
                        const f32x4 o0 = {sm[0] * inv - bf_lo(cv.x), sm[1] * inv - bf_hi(cv.x), sm[2] * inv - bf_lo(cv.y), sm[3] * inv - bf_hi(cv.y)};
                        const f32x4 o1 = {sm[4] * inv - bf_lo(cv.z), sm[5] * inv - bf_hi(cv.z), sm[6] * inv - bf_lo(cv.w), sm[7] * inv - bf_hi(cv.w)};
                        *(u32x2*)(mixed + (size_t)(b * SEQ + t) * DM + ch0 + cq * 8) = g8::pack8_fp8(o0, o1); }
                }
            }
            if (dov) {
#pragma unroll
                for (int k = 0; k < 4; ++k) { const int it = it0 + k * NGV, tok = tilewise ? (X.bid & 63) * 256 + (it >> 6) : it >> 8, q = tilewise ? (X.bid >> 6) * 64 + (it & 63) : it & 255;
                    const u32x4 a = va[k], r = vr[k]; u32x4 e, o;
                    e.x = cvt_pk_bf16(0.5f * (bf_lo(a.x) + bf_lo(r.x)), 0.5f * (bf_hi(a.x) + bf_hi(r.x))); o.x = cvt_pk_bf16(0.5f * (bf_lo(a.x) - bf_lo(r.x)), 0.5f * (bf_hi(a.x) - bf_hi(r.x)));
                    e.y = cvt_pk_bf16(0.5f * (bf_lo(a.y) + bf_lo(r.y)), 0.5f * (bf_hi(a.y) + bf_hi(r.y))); o.y = cvt_pk_bf16(0.5f * (bf_lo(a.y) - bf_lo(r.y)), 0.5f * (bf_hi(a.y) - bf_hi(r.y)));
                    e.z = cvt_pk_bf16(0.5f * (bf_lo(a.z) + bf_lo(r.z)), 0.5f * (bf_hi(a.z) + bf_hi(r.z))); o.z = cvt_pk_bf16(0.5f * (bf_lo(a.z) - bf_lo(r.z)), 0.5f * (bf_hi(a.z) - bf_hi(r.z)));
                    e.w = cvt_pk_bf16(0.5f * (bf_lo(a.w) + bf_lo(r.w)), 0.5f * (bf_hi(a.w) + bf_hi(r.w))); o.w = cvt_pk_bf16(0.5f * (bf_lo(a.w) - bf_lo(r.w)), 0.5f * (bf_hi(a.w) - bf_hi(r.w)));
                    const int h = q >> 6, j = (q & 63) * 8;
                    *(u32x4*)(vv + (size_t)tok * DM + h * 1024 + j) = e; *(u32x4*)(vv + (size_t)tok * DM + h * 1024 + 512 + j) = o; }
            }
            if (dop) __syncthreads();
            w += X.G; it0 += 4 * NGV;
        }
    }
}

typedef short s16x4 __attribute__((ext_vector_type(4)));
constexpr int FT_PITCH = 544;
__device__ __forceinline__ bf16x8 fft_afrag(const LAS unsigned char* tile, int lane, int ks, int cb  ) {
    const int g = lane >> 4, q = (lane & 15) >> 2, pp = lane & 3;
    const LAS unsigned char* a0 = tile + (32 * ks + 8 * g + q) * FT_PITCH + (cb + 4 * pp) * 2;
    const s16x4 lo = __builtin_amdgcn_ds_read_tr16_b64_v4i16((LAS s16x4*)a0), hi = __builtin_amdgcn_ds_read_tr16_b64_v4i16((LAS s16x4*)(a0 + 4 * FT_PITCH));
    return __builtin_shufflevector(lo, hi, 0, 1, 2, 3, 4, 5, 6, 7);
}
__device__ __forceinline__ bf16x8 pack_frag(const float (&f)[8]) {
    u32x4 w; w.x = cvt_pk_bf16(f[0], f[1]); w.y = cvt_pk_bf16(f[2], f[3]); w.z = cvt_pk_bf16(f[4], f[5]); w.w = cvt_pk_bf16(f[6], f[7]); return __builtin_bit_cast(bf16x8, w);
}
__device__ __forceinline__ void p5a_fft1(const Ctx& X) {
    const Params& p = *X.p; unsigned char* ws = p.ws;
    const bf16_t* Q = (const bf16_t*)(ws + E_QT); bf16_t* T = (bf16_t*)(ws + E_T);
    LAS unsigned char* tile = X.lds; LAS float* cs = (LAS float*)(X.lds + 98304);
    if (X.tid < 64) { float sn, c; sincospif((float)X.tid * (1.0f / 32.0f), &sn, &c); cs[X.tid] = c; cs[64 + X.tid] = sn; }
    __syncthreads();
    const int fr = X.lane & 15, fq = X.lane >> 4, cbw = X.wave * 32;
    bf16x8 bfr[8][2];
#pragma unroll
    for (int ni = 0; ni < 8; ++ni)
#pragma unroll
        for (int ks = 0; ks < 2; ++ks) { float f[8];
#pragma unroll
            for (int j = 0; j < 8; ++j) { const int k1 = (16 * ni + fr) & 63, n1 = 32 * ks + 8 * fq + j, m = (k1 * n1) & 63; f[j] = (ni < 4) ? cs[m] : -cs[64 + m]; }
            bfr[ni][ks] = pack_frag(f); }
    u32x4 ld[4];
    int it = X.bid;
    auto issue = [&](int item) { const int b = item >> 9, n2 = (item >> 3) & 63, ch = item & 7;
#pragma unroll
        for (int i = 0; i < 4; ++i) { const int q = X.tid + 512 * i, n1 = q >> 5, pc = q & 31; ld[i] = __builtin_nontemporal_load((const u32x4*)(Q + (size_t)(b * SEQ + 64 * n1 + n2) * 2048 + ch * 256 + pc * 8)); } };
    if (it < 2048) issue(it);
    for (; it < 2048; it += X.G) {
        const int b = it >> 9, n2 = (it >> 3) & 63, ch = it & 7;
#pragma unroll
        for (int i = 0; i < 4; ++i) { const int q = X.tid + 512 * i; *(LAS u32x4*)(tile + (q >> 5) * FT_PITCH + (q & 31) * 16) = ld[i]; }
        __syncthreads();
        if (it + X.G < 2048) issue(it + X.G);
        f32x4 acc[2][8]; f32x4 zz = {0.f, 0.f, 0.f, 0.f}; asm volatile("" : "+v"(zz));
#pragma unroll
        for (int mf = 0; mf < 2; ++mf)
#pragma unroll
            for (int ni = 0; ni < 8; ++ni) acc[mf][ni] = zz;
#pragma unroll
        for (int mf = 0; mf < 2; ++mf)
#pragma unroll
            for (int ks = 0; ks < 2; ++ks) { const bf16x8 af = fft_afrag(tile, X.lane, ks, cbw + 16 * mf);
#pragma unroll
                for (int ni = 0; ni < 8; ++ni) asm volatile("v_mfma_f32_16x16x32_bf16 %0, %1, %2, %0" : "+v"(acc[mf][ni]) : "v"(af), "v"(bfr[ni][ks])); }
        asm volatile("s_nop 15\n\ts_nop 15" ::: "memory");
#pragma unroll
        for (int ni = 0; ni < 4; ++ni) { const int k1 = 16 * ni + fr; const float rev = (float)(n2 * k1) * (1.0f / 4096.0f); const float sn = __builtin_amdgcn_sinf(rev), c = __builtin_amdgcn_cosf(rev);
            bf16_t* tr = T + ((size_t)((b * 64 + k1) * 64 + n2) * 2) * 2048 + ch * 256 + cbw + 4 * fq;
#pragma unroll
            for (int mf = 0; mf < 2; ++mf) { const f32x4 re = acc[mf][ni], im = acc[mf][ni + 4];
                const f32x4 t_r = re * c + im * sn, t_i = im * c - re * sn;
                u32x2 w; w.x = cvt_pk_bf16(t_r[0], t_r[1]); w.y = cvt_pk_bf16(t_r[2], t_r[3]); *(u32x2*)(tr + 16 * mf) = w;
                w.x = cvt_pk_bf16(t_i[0], t_i[1]); w.y = cvt_pk_bf16(t_i[2], t_i[3]); *(u32x2*)(tr + 2048 + 16 * mf) = w; } }
        __syncthreads();
    }
}
__device__ __forceinline__ void p5b_fft2(const Ctx& X) {
    const Params& p = *X.p; unsigned char* ws = p.ws;
    const bf16_t* T = (const bf16_t*)(ws + E_T); unsigned char* mixed = ws + E_MIXED;
    LAS unsigned char* tile = X.lds; LAS float* cs = (LAS float*)(X.lds + 98304);
    if (X.tid < 64) { float sn, c; sincospif((float)X.tid * (1.0f / 32.0f), &sn, &c); cs[X.tid] = c; cs[64 + X.tid] = sn; }
    __syncthreads();
    const int fr = X.lane & 15, fq = X.lane >> 4, cbw = X.wave * 32;
    const float sc = 1.0f / sqrtf((float)SEQ * 512.0f);
    bf16x8 bfr[4][4];
#pragma unroll
    for (int ni = 0; ni < 4; ++ni)
#pragma unroll
        for (int ks = 0; ks < 4; ++ks) { float f[8];
#pragma unroll
            for (int j = 0; j < 8; ++j) { const int k2 = 16 * ni + fr, kk = 32 * ks + 8 * fq + j, n2 = kk >> 1, m = (k2 * n2) & 63; const float c = cs[m], sn = cs[64 + m]; f[j] = ((kk & 1) ? (c + sn) : (c - sn)) * sc; }
            bfr[ni][ks] = pack_frag(f); }
    u32x4 ld[8];
    int it = X.bid;
    auto issue = [&](int item) { const int b = item >> 9, k1 = (item >> 3) & 63, ch = item & 7;
#pragma unroll
        for (int i = 0; i < 8; ++i) { const int q = X.tid + 512 * i, kk = q >> 5, pc = q & 31; ld[i] = __builtin_nontemporal_load((const u32x4*)(T + ((size_t)(b * 64 + k1) * 128 + kk) * 2048 + ch * 256 + pc * 8)); } };
    if (it < 2048) issue(it);
    for (; it < 2048; it += X.G) {
        const int b = it >> 9, k1 = (it >> 3) & 63, ch = it & 7;
#pragma unroll
        for (int i = 0; i < 8; ++i) { const int q = X.tid + 512 * i; *(LAS u32x4*)(tile + (q >> 5) * FT_PITCH + (q & 31) * 16) = ld[i]; }
        __syncthreads();
        if (it + X.G < 2048) issue(it + X.G);
        f32x4 acc[2][4]; f32x4 zz = {0.f, 0.f, 0.f, 0.f}; asm volatile("" : "+v"(zz));
#pragma unroll
        for (int mf = 0; mf < 2; ++mf)
#pragma unroll
            for (int ni = 0; ni < 4; ++ni) acc[mf][ni] = zz;
#pragma unroll
        for (int mf = 0; mf < 2; ++mf)
#pragma unroll
            for (int ks = 0; ks < 4; ++ks) { const bf16x8 af = fft_afrag(tile, X.lane, ks, cbw + 16 * mf);
#pragma unroll
                for (int ni = 0; ni < 4; ++ni) asm volatile("v_mfma_f32_16x16x32_bf16 %0, %1, %2, %0" : "+v"(acc[mf][ni]) : "v"(af), "v"(bfr[ni][ks])); }
        asm volatile("s_nop 15\n\ts_nop 15" ::: "memory");
#pragma unroll
        for (int ni = 0; ni < 4; ++ni) { const int k2 = 16 * ni + fr;
            unsigned char* o = mixed + (size_t)(b * SEQ + k1 + 64 * k2) * DM + 2048 + ch * 256 + cbw + 4 * fq;
#pragma unroll
            for (int mf = 0; mf < 2; ++mf) { const f32x4 v = acc[mf][ni]; int w = 0; w = __builtin_amdgcn_cvt_pk_fp8_f32(v[0], v[1], w, false); w = __builtin_amdgcn_cvt_pk_fp8_f32(v[2], v[3], w, true); *(int*)(o + 16 * mf) = w; } }
        __syncthreads();
    }
}

__device__ __forceinline__ void p7_router(const Ctx& X, const size_t tb  , const size_t cb) {
    const Params& p = *X.p; unsigned char* ws = p.ws;
    const bf16_t* h1 = (const bf16_t*)(ws + WS_H1B); const bf16_t* rwt = (const bf16_t*)(ws + WS_RWT);
    int* rowtok = (int*)(ws + WS_ROWTOK + tb); float* rowrstd = (float*)(ws + WS_ROWRSTD + tb); float* rowgate = (float*)(ws + WS_ROWGATE + tb); int* rowdst = (int*)(ws + WS_ROWDST + tb);
    unsigned* gcnt = (unsigned*)(ws + WS_CTL + CTL_CNT + cb);
    LAS float* part = (LAS float*)X.lds;
    LAS float* ssq = (LAS float*)(X.lds + LX_RT);
    LAS float* lg = (LAS float*)(X.lds + LX_RT + 2048);
    LAS int* lcnt = (LAS int*)(X.lds + LX_RT + 2048 + 8192);
    LAS int* gb = lcnt + 32;
    LAS float* rstl = (LAS float*)(X.lds + LX_RT + 2048 + 8192 + 256);
    LAS float* gvs = (LAS float*)(X.lds + LX_RT + 2048 + 8192 + 512);
    for (int tt = X.bid; tt < NTOK / 64; tt += X.G) {
        int lzq = g8::lane_id_v();
        const int fr = lzq & 15, fq = lzq >> 4;
        const int tok0 = tt * 64;
        f32x4 acc[4][4]; float ss[4] = {0.f, 0.f, 0.f, 0.f};
#pragma unroll
        for (int a = 0; a < 4; ++a)
#pragma unroll
            for (int b = 0; b < 4; ++b) acc[a][b] = (f32x4){0.f, 0.f, 0.f, 0.f};
        {
        LAS unsigned char* wreg = X.lds + X.wave * 16384;
        const int l16 = lzq & 15, l4 = lzq >> 4;
        bf16x8 ld[16], bfb[4][4];
        const __amdgpu_buffer_rsrc_t rsH = __builtin_amdgcn_make_buffer_rsrc((void*)(h1 + (size_t)tok0 * DM), (short)0, (int)(64 * DM * 2), 0x00020000);
        const __amdgpu_buffer_rsrc_t rsR = __builtin_amdgcn_make_buffer_rsrc((void*)rwt, (short)0, (int)(64 * DM * 2), 0x00020000);
        const int vH = l4 * (DM * 2) + X.wave * 1024 + l16 * 16, vR = fr * (DM * 2) + X.wave * 1024 + fq * 16;
#define P7_GLOAD(q) do { _Pragma("unroll") for (int j = 0; j < 16; ++j) ld[j] = __builtin_bit_cast(bf16x8, __builtin_amdgcn_raw_buffer_load_b128(rsH, vH, j * (4 * DM * 2) + (q) * 256, 2)); } while (0)
        LAS unsigned char* wb[4]; LAS const unsigned char* rb[4];
#pragma unroll
        for (int jj = 0; jj < 4; ++jj) { const int row = 4 * jj + l4; wb[jj] = wreg + row * 256 + ((l16 ^ (row & 15)) * 16); rb[jj] = wreg + fr * 256 + (((jj * 4 + fq) ^ fr) * 16); }
#define P7_LWRITE() do { _Pragma("unroll") for (int j = 0; j < 16; ++j) *(LAS bf16x8*)(wb[j & 3] + (j >> 2) * 4096) = ld[j]; } while (0)
#define P7_BLOAD(st, kk) do { _Pragma("unroll") for (int ni = 0; ni < 4; ++ni) bfb[st][ni] = __builtin_bit_cast(bf16x8, __builtin_amdgcn_raw_buffer_load_b128(rsR, vR, ni * (16 * DM * 2) + (kk) * 64, 0)); } while (0)
        P7_GLOAD(0);
#pragma unroll 1
        for (int q = 0; q < 4; ++q) {
            P7_LWRITE();
            __builtin_amdgcn_sched_barrier(0);
            P7_BLOAD(0, q * 4); P7_BLOAD(1, q * 4 + 1); P7_BLOAD(2, q * 4 + 2); P7_BLOAD(3, q * 4 + 3);
            __builtin_amdgcn_sched_barrier(0);
            { const int qn = q < 3 ? q + 1 : 3; P7_GLOAD(qn); }
            __builtin_amdgcn_sched_barrier(0);
#pragma unroll
            for (int ks = 0; ks < 4; ++ks) {
                __builtin_amdgcn_sched_barrier(0);
#pragma unroll
                for (int mi = 0; mi < 4; ++mi) {
                    const bf16x8 af = *(const LAS bf16x8*)(rb[ks] + mi * 4096);
#pragma unroll
                    for (int j = 0; j < 8; ++j) { const float f = __uint_as_float(((unsigned)(unsigned short)af[j]) << 16); ss[mi] += f * f; }
#pragma unroll
                    for (int ni = 0; ni < 4; ++ni) asm volatile("v_mfma_f32_16x16x32_bf16 %0, %1, %2, %0" : "+v"(acc[mi][ni]) : "v"(af), "v"(bfb[ks & 3][ni]));
                }
                __builtin_amdgcn_sched_barrier(0);
            }
        }
        asm volatile("s_nop 15\n\ts_nop 15" ::: "memory");
        __builtin_amdgcn_s_waitcnt(0);
#undef P7_GLOAD
#undef P7_LWRITE
#undef P7_BLOAD
        }
        const int tq = X.wave * 64 + g8::lane_id_v();
#pragma unroll
        for (int mi = 0; mi < 4; ++mi) {
#pragma unroll
            for (int ni = 0; ni < 4; ++ni)
#pragma unroll
                for (int r = 0; r < 4; ++r) part[(X.wave * 64 + mi * 16 + 4 * fq + r) * 64 + ni * 16 + fr] = acc[mi][ni][r];
            float s = ss[mi]; s += __shfl_xor(s, 16); s += __shfl_xor(s, 32);
            if (fq == 0) ssq[X.wave * 64 + mi * 16 + fr] = s;
        }
        if (tq < 32) lcnt[tq] = 0;
        __syncthreads();
        {   const int tk = tq >> 3, eg = tq & 7;
            float sq = 0.f;
#pragma unroll
            for (int w = 0; w < 8; ++w) sq += ssq[w * 64 + tk];
            const float rstd = rsqrtf(sq * (1.0f / DM) + RMS_EPS);
#pragma unroll
            for (int j = 0; j < 4; ++j) { const int e = eg * 4 + j; float a = 0.f;
#pragma unroll
                for (int w = 0; w < 8; ++w) a += part[(w * 64 + tk) * 64 + e] + part[(w * 64 + tk) * 64 + 32 + e];
                lg[tk * 32 + e] = a * rstd + p.in[I_RB][e]; }
            if (eg == 0) rstl[tk] = rstd;
        }
        __syncthreads();
        int ei[4]; float gv[4]; int lp[4]; float rstd_t = 0.f;
        if (tq < 64) {
            const int tk = tq; rstd_t = rstl[tk];
            float tv[4];
#pragma unroll
            for (int k = 0; k < 4; ++k) { float best = -3.0e38f; int bi = 0;
                for (int e = 0; e < 32; ++e) { const float v = lg[tk * 32 + e]; if (v > best) { best = v; bi = e; } }
                tv[k] = best; ei[k] = bi; lg[tk * 32 + bi] = -3.0e38f; }
            float den = 0.f;
#pragma unroll
            for (int k = 0; k < 4; ++k) { gv[k] = __expf(tv[k] - tv[0]); den += gv[k]; }
            const float inv = 1.0f / den;
#pragma unroll
            for (int k = 0; k < 4; ++k) { gvs[tk * 4 + k] = gv[k] * inv; lp[k] = atomicAdd((int*)&lcnt[ei[k]], 1); }
        }
        __syncthreads();
        if (tq < 32) { const int n = lcnt[tq]; gb[tq] = n ? (int)atomicAdd(&gcnt[tq], (unsigned)n) : 0; }
        __syncthreads();
        if (tq < 64) {
            const int tok = tok0 + tq;
#pragma unroll
            for (int k = 0; k < 4; ++k) { const int idx = ei[k] * CAP + gb[ei[k]] + lp[k];
                rowtok[idx] = tok; rowrstd[idx] = rstd_t; rowgate[idx] = gvs[tq * 4 + k]; rowdst[idx] = tok * 4 + k; }
        }
        __syncthreads();
    }
}

__device__ __forceinline__ int moe_tables(const Ctx& X) {
    const unsigned* gcnt = (const unsigned*)(X.p->ws + WS_CTL + CTL_CNT);
    int* tab = (int*)(X.p->ws + WS_TABG) + (size_t)X.bid * 2048;
    if (X.tid < 64) {
        const int e = X.lane & 31;
        const int c = (int)__hip_atomic_load(gcnt + e, __ATOMIC_RELAXED, __HIP_MEMORY_SCOPE_AGENT), nt = (c + 255) >> 8;
        int rb = c, ts = nt;
#pragma unroll
        for (int o = 1; o < 32; o <<= 1) { const int r2 = __shfl_up(rb, o), t2 = __shfl_up(ts, o); if (e >= o) { rb += r2; ts += t2; } }
        if (X.lane < 32) { const int rb0 = rb - c, ts0 = ts - nt;
            for (int j = 0; j < nt; ++j) { int* r = tab + 4 + 4 * (ts0 + j); r[0] = e; r[1] = j; r[2] = c; r[3] = rb0; }
            if (e == 31) tab[0] = ts; }
    }
    asm volatile("s_waitcnt vmcnt(0)" ::: "memory");
    __syncthreads();
    return __builtin_amdgcn_readfirstlane(__hip_atomic_load(tab, __ATOMIC_RELAXED, __HIP_MEMORY_SCOPE_AGENT));
}

__device__ __forceinline__ void p10_combine(const Ctx& X) {
    const Params& p = *X.p; unsigned char* ws = p.ws;
    const bf16_t* h1 = (const bf16_t*)(ws + WS_H1B); const unsigned char* y = ws + E_Y; const float* gf = p.in[I_GF]; float* out = p.out;
    const int gw = X.bid * 8 + X.wave, NGW = X.G * 8;
    for (int tok = gw; tok < NTOK; tok += NGW) {
        float v[8][8]; float ss = 0.f;
#pragma unroll
        for (int ib = 0; ib < 8; ib += 4) {
            u32x4 a[4]; u32x2 yk[4][4];
#pragma unroll
            for (int ii = 0; ii < 4; ++ii) { const int c = ((ib + ii) * 64 + X.lane) * 8;
                a[ii] = __builtin_nontemporal_load((const u32x4*)(h1 + (size_t)tok * DM + c));
#pragma unroll
                for (int k = 0; k < 4; ++k) yk[ii][k] = __builtin_nontemporal_load((const u32x2*)(y + ((size_t)tok * 4 + k) * DM + c)); }
#pragma unroll
            for (int ii = 0; ii < 4; ++ii) { const int i = ib + ii; const u32x4 w = a[ii];
                float s8[8] = {0.f, 0.f, 0.f, 0.f, 0.f, 0.f, 0.f, 0.f};
#pragma unroll
                for (int k = 0; k < 4; ++k) {
                    const f32x2 p0 = __builtin_amdgcn_cvt_pk_f32_fp8((int)yk[ii][k].x, false), p1 = __builtin_amdgcn_cvt_pk_f32_fp8((int)yk[ii][k].x, true);
                    const f32x2 p2 = __builtin_amdgcn_cvt_pk_f32_fp8((int)yk[ii][k].y, false), p3 = __builtin_amdgcn_cvt_pk_f32_fp8((int)yk[ii][k].y, true);
                    s8[0] += p0.x; s8[1] += p0.y; s8[2] += p1.x; s8[3] += p1.y; s8[4] += p2.x; s8[5] += p2.y; s8[6] += p3.x; s8[7] += p3.y; }
                v[i][0] = bf_lo(w.x) + 0.125f * s8[0]; v[i][1] = bf_hi(w.x) + 0.125f * s8[1]; v[i][2] = bf_lo(w.y) + 0.125f * s8[2]; v[i][3] = bf_hi(w.y) + 0.125f * s8[3];
                v[i][4] = bf_lo(w.z) + 0.125f * s8[4]; v[i][5] = bf_hi(w.z) + 0.125f * s8[5]; v[i][6] = bf_lo(w.w) + 0.125f * s8[6]; v[i][7] = bf_hi(w.w) + 0.125f * s8[7];
#pragma unroll
                for (int j = 0; j < 8; ++j) ss += v[i][j] * v[i][j]; }
            asm volatile("" ::: "memory");
        }
        ss = wave_sum(ss);
        const float rstd = rsqrtf(ss * (1.0f / DM) + RMS_EPS);
#pragma unroll
        for (int i = 0; i < 8; ++i) { const int c = (i * 64 + X.lane) * 8;
            const f32x4 g0 = *(const f32x4*)(gf + c), g1 = *(const f32x4*)(gf + c + 4);
            f32x4 o0, o1;
#pragma unroll
            for (int j = 0; j < 4; ++j) { o0[j] = v[i][j] * rstd * g0[j]; o1[j] = v[i][4 + j] * rstd * g1[j]; }
            __builtin_nontemporal_store(o0, (f32x4*)(out + (size_t)tok * DM + c)); __builtin_nontemporal_store(o1, (f32x4*)(out + (size_t)tok * DM + c + 4)); }
    }
}

__global__ void __launch_bounds__(NTHREADS, 2) mk_fwd(Params prm) {
    extern __shared__ __attribute__((aligned(16))) unsigned char lds_raw[];
    Ctx X; X.p = &prm; X.lds = (LAS unsigned char*)lds_raw; X.tid = threadIdx.x; X.lane = X.tid & 63; X.wave = __builtin_amdgcn_readfirstlane(X.tid >> 6); X.G = gridDim.x; X.bid = blockIdx.x;
#define RECTX() do { int _lz = (int)__builtin_amdgcn_mbcnt_hi(~0u, __builtin_amdgcn_mbcnt_lo(~0u, 0u)); asm volatile("" : "+v"(_lz)); X.lane = _lz; X.tid = X.wave * 64 + _lz; } while (0)
    unsigned char* ws = prm.ws;
    const int lo = prm.ph_lo, hi = prm.ph_hi;
#if !MK_PER_PHASE
    if (X.tid == 0) *(LAS u32x4*)(X.lds + LX_BAR) = (u32x4){0u, 0u, 0u, 0u};
    __syncthreads();
    XcdBarrier bar = xcd_barrier_post((unsigned*)(ws + WS_CTL), (volatile LAS unsigned*)(X.lds + LX_BAR));
#define GRID_BAR() xcd_barrier(bar, X.wave == 0 && g8::lane_id_v() == 0)
#else
#define GRID_BAR() do {} while (0)
#endif
#ifdef MK_ONLY
#define IN(k) ((k) == MK_ONLY)
#else
#define IN(k) (lo <= (k) && (k) < hi)
#endif
#define SEAM(k) do { if (IN((k) + 1)) GRID_BAR(); } while (0)
    LAS unsigned char* stage = X.lds;

    if (IN(0)) { RECTX(); p0_prep(X); if (MK_DOUBLE == 0) { __syncthreads(); p0_prep(X); } SEAM(0); }

    if (IN(1)) {
        {   g8::DenseP<0> P{}; P.A = (const char*)(ws + WS_PWT); P.B = (const char*)(ws + E_WINP); P.C = (bf16_t*)(ws + E_WINT);
            P.lda2 = 1024; P.ldb2 = 4096; P.nt = 8; P.nM = 8; P.nN = 16; P.G = X.G; P.c = X.bid; P.mPer = 2; P.bDiv = 1; P.ldc = 4096;
            P.aHi = 512 * 512 * 2; P.aLo = 0; P.bHi = 512 * 2; P.bLo = 0; P.cHi = (size_t)512 * 4096; P.cLo = 0; P.rowscale = nullptr; P.resid = nullptr;
            g8::gemm_phase(stage, P, X.wave); }
        {   g8::DenseP<0> P{}; P.A = (const char*)(ws + WS_FWT); P.B = (const char*)(ws + WS_DFTC); P.C = (bf16_t*)(ws + WS_GT);
            P.lda2 = 1024; P.ldb2 = 1024; P.nt = 8; P.nM = 8; P.nN = 4; P.G = X.G; P.c = (X.bid + 128) % X.G; P.mPer = 2; P.bDiv = 1; P.ldc = 1024;
            P.aHi = 512 * 512 * 2; P.aLo = 0; P.bHi = 0; P.bLo = 0; P.cHi = (size_t)512 * 1024; P.cLo = 0; P.rowscale = nullptr; P.resid = nullptr;
            g8::gemm_phase(stage, P, X.wave); }
        SEAM(1);
    }

    if (IN(2)) { RECTX();
        g8::DenseP<1, false, 1> P{}; P.A = (const char*)(ws + E_XB); P.B = (const char*)(ws + E_WINT); P.C = (bf16_t*)(ws + E_U);
        P.lda2 = 8192; P.ldb2 = 8192; P.nt = 64; P.nM = 64; P.nN = 16; P.G = X.G; P.c = X.bid; P.mPer = 64; P.bDiv = 1; P.ldc = 4096;
        P.aHi = 0; P.aLo = 0; P.bHi = 0; P.bLo = 0; P.cHi = 0; P.cLo = 0; P.rowscale = (const float*)(ws + WS_RSTD1); P.resid = nullptr;
        const int nun = X.bid < 64 * 16 ? (64 * 16 - X.bid + X.G - 1) / X.G : 0, per = X.bid < T8_WD ? (T8_WD - X.bid + X.G - 1) / X.G : 0, inl = min(per, nun * 64 / 8);
        P.ssrc0 = prm.in[I_WG]; P.ssrc1 = prm.in[I_WU]; P.sdst = ws + WS_WGU; P.sbid = X.bid; P.sk1 = inl;
        for (int rep = 0; rep < (MK_DOUBLE == 2 ? 2 : 1); ++rep) g8::gemm_phase(stage, P, X.wave);
        RECTX(); convert_tiles8(X, 0, T8_WD, inl, 1 << 30);
        SEAM(2);
    }

    const bool f34 = (X.G == 256) && IN(3) && IN(4);
    if (IN(3)) { RECTX(); p3_mix_prep(X, f34); if (MK_DOUBLE == 3) { __syncthreads(); p3_mix_prep(X, f34); }
        if (f34) { asm volatile("s_waitcnt vmcnt(0)" ::: "memory"); __syncthreads(); } else SEAM(3); }

    if (IN(4)) {
        g8::DenseP<0, false, 3> P{}; P.A = (const char*)(ws + E_VEVO); P.B = (const char*)(ws + WS_GT); P.C = (bf16_t*)(ws + E_QT);
        P.lda2 = 8192; P.ldb2 = 2048; P.nt = 16; P.nM = 256; P.nN = 2; P.G = X.G; P.c = X.bid; P.mPer = 64; P.bDiv = 1; P.ldc = 2048;
        P.aHi = 1024 * 2; P.aLo = 0; P.bHi = 512 * 1024 * 2; P.bLo = 0; P.cHi = 512; P.cLo = 0; P.rowscale = nullptr; P.resid = nullptr; P.direct = f34 ? 1 : 0;
        const int nun = X.bid < 512 ? (512 - X.bid + X.G - 1) / X.G : 0, per = X.bid < NT_WOUT ? (NT_WOUT - X.bid + X.G - 1) / X.G : 0, inl = min(per, nun * 16 / 8);
        P.ssrc0 = prm.in[I_WOUT]; P.ssrc1 = nullptr; P.sdst = ws + E_WOUTT; P.sbid = X.bid; P.sk1 = inl;
        for (int rep = 0; rep < (MK_DOUBLE == 4 ? 2 : 1); ++rep) g8::gemm_phase(stage, P, X.wave);
        RECTX(); convert_tiles8(X, NT_F8, T8_WOUT_END, inl, 1 << 30);
        SEAM(4);
    }

    if (IN(5)) { RECTX();
        p5a_fft1(X);
        GRID_BAR();
        RECTX(); p5b_fft2(X);
        SEAM(5);
    }

    if (IN(6)) { RECTX();
        g8::DenseP<2, true, 2> P{}; P.A = (const char*)(ws + E_MIXED); P.B = (const char*)(ws + E_WOUTT); P.C = (bf16_t*)(ws + WS_H1B); P.C8 = ws + WS_H1F8; P.oscale = 1.0f / 64.0f;
        P.lda2 = 4096; P.ldb2 = 4096; P.nt = 32; P.nM = 64; P.nN = 16; P.G = X.G; P.c = X.bid; P.mPer = 64; P.bDiv = 1; P.ldc = 4096;
        P.aHi = 0; P.aLo = 0; P.bHi = 0; P.bLo = 0; P.cHi = 0; P.cLo = 0; P.rowscale = prm.in[I_G2]; P.resid = nullptr; P.residb = (const bf16_t*)(ws + E_XB);
        const int nun = X.bid < 64 * 16 ? (64 * 16 - X.bid + X.G - 1) / X.G : 0, per = X.bid < NT_EXP ? (NT_EXP - X.bid + X.G - 1) / X.G : 0, inl = min(per, nun * 32 / 8);
        P.ssrc0 = prm.in[I_WD]; P.ssrc1 = nullptr; P.sdst = ws + WS_WD; P.sbid = X.bid; P.sk1 = inl;
        for (int rep = 0; rep < (MK_DOUBLE == 6 ? 2 : 1); ++rep) g8::gemm_phase(stage, P, X.wave);
        RECTX(); convert_tiles8(X, T8_WD, NT_F8, inl, 1 << 30);
        SEAM(6);
    }

    if (IN(7)) { RECTX(); p7_router(X, 0, 0);
#if MK_DOUBLE == 7
        __syncthreads(); p7_router(X, E_U - WS_ROWTOK, 4096);
#endif
        SEAM(7); }

    if (IN(8)) { RECTX();
        const int T = moe_tables(X);
        g8::MoeGateUpP P{}; P.m0 = 0; P.nMv = T < 256 ? T : 256; P.A = (const char*)(ws + WS_H1F8); P.B = (const char*)(ws + WS_WGU); P.lda2 = 4096; P.ldb2 = 4096; P.nt = 32; P.G = X.G; P.c = X.bid;
        P.tab = (const int*)(ws + WS_TABG) + (size_t)X.bid * 2048; P.rowtok = (const int*)(ws + WS_ROWTOK); P.rowrstd = (const float*)(ws + WS_ROWRSTD);
        P.bgate = prm.in[I_BG]; P.bup = prm.in[I_BU]; P.act = ws + WS_ACT; P.preload();
        for (int rep = 0; rep < (MK_DOUBLE == 8 ? 2 : 1); ++rep) g8::gemm_phase(stage, P, X.wave);
        SEAM(8);
    }

    if (IN(9)) { RECTX();
        const int T = moe_tables(X);
        const int Lr = T > 256 ? T - 256 : 0;
        if (Lr > 0) {
            g8::MoeGateUpP P{}; P.m0 = 256; P.nMv = Lr; P.A = (const char*)(ws + WS_H1F8); P.B = (const char*)(ws + WS_WGU); P.lda2 = 4096; P.ldb2 = 4096; P.nt = 32; P.G = X.G; P.c = X.bid;
            P.tab = (const int*)(ws + WS_TABG) + (size_t)X.bid * 2048; P.rowtok = (const int*)(ws + WS_ROWTOK); P.rowrstd = (const float*)(ws + WS_ROWRSTD);
            P.bgate = prm.in[I_BG]; P.bup = prm.in[I_BU]; P.act = ws + WS_ACT; P.preload();
            g8::gemm_phase(stage, P, X.wave);
        }
        {   g8::MoeDownP P{}; P.mode = 0; P.nbusy = (4 * Lr < X.G) ? 4 * Lr : X.G; P.m0 = 0; P.nMv = T < 256 ? T : 256;
            P.A = (const char*)(ws + WS_ACT); P.B = (const char*)(ws + WS_WD); P.lda2 = 512; P.ldb2 = 512; P.nt = 4; P.G = X.G; P.c = X.bid;
            P.tab = (const int*)(ws + WS_TABG) + (size_t)X.bid * 2048; P.rowdst = (const int*)(ws + WS_ROWDST); P.rowgate = (const float*)(ws + WS_ROWGATE);
            P.bdown = prm.in[I_BD]; P.y = ws + E_Y; P.preload();
            for (int rep = 0; rep < (MK_DOUBLE == 9 ? 2 : 1); ++rep) g8::gemm_phase(stage, P, X.wave); }
        if (Lr > 0) {
            GRID_BAR();
            g8::MoeDownP P{}; P.mode = 1; P.nbusy = 0; P.m0 = 256; P.nMv = Lr;
            P.A = (const char*)(ws + WS_ACT); P.B = (const char*)(ws + WS_WD); P.lda2 = 512; P.ldb2 = 512; P.nt = 4; P.G = X.G; P.c = X.bid;
            P.tab = (const int*)(ws + WS_TABG) + (size_t)X.bid * 2048; P.rowdst = (const int*)(ws + WS_ROWDST); P.rowgate = (const float*)(ws + WS_ROWGATE);
            P.bdown = prm.in[I_BD]; P.y = ws + E_Y; P.preload();
            g8::gemm_phase(stage, P, X.wave);
        }
        SEAM(9);
    }

    if (IN(10)) { RECTX(); p10_combine(X); if (MK_DOUBLE == 10) { __syncthreads(); p10_combine(X); } }
#undef RECTX
#undef IN
#undef SEAM
#undef GRID_BAR
}

extern "C" void kernel_launch(void* const* d_in, const int* in_sizes, int n_in, void* d_out, int out_size, void* d_ws, size_t ws_size, hipStream_t stream) {
    static int grid = 0;
    if (grid == 0) {
        if (n_in != 17 || in_sizes[0] != NTOK * DM || out_size != NTOK * DM || ws_size < WS_END) { fprintf(stderr, "kernel_launch: unexpected shapes / workspace (n_in %d, ws %zu, need %zu); nothing launched\n", n_in, ws_size, (size_t)WS_END); grid = -1; return; }
        int dev = 0, cus = 0, per_cu = 0;
        if (hipGetDevice(&dev) != hipSuccess || hipDeviceGetAttribute(&cus, hipDeviceAttributeMultiprocessorCount, dev) != hipSuccess) { grid = -1; return; }
        if (hipFuncSetAttribute((const void*)mk_fwd, hipFuncAttributeMaxDynamicSharedMemorySize, LDS_BYTES) != hipSuccess) { fprintf(stderr, "kernel_launch: hipFuncSetAttribute failed\n"); grid = -1; return; }
        if (hipOccupancyMaxActiveBlocksPerMultiprocessor(&per_cu, (const void*)mk_fwd, NTHREADS, LDS_BYTES) != hipSuccess || per_cu < 1) { fprintf(stderr, "kernel_launch: occupancy query says %d\n", per_cu); (void)hipGetLastError(); per_cu = 1; }
        grid = cus;
    }
    if (grid < 0) return;
    if (hipMemsetAsync((char*)d_ws + WS_CTL, 0, CTL_BYTES, stream) != hipSuccess) return;
    Params a{};
    for (int i = 0; i < 17; ++i) a.in[i] = (const float*)d_in[i];
    a.out = (float*)d_out; a.ws = (unsigned char*)d_ws;
#if MK_PER_PHASE
    for (int ph = 0; ph < NPHASES; ++ph) { a.ph_lo = ph; a.ph_hi = ph + 1; hipLaunchKernelGGL(mk_fwd, dim3(grid), dim3(NTHREADS), LDS_BYTES, stream, a); }
#else
    a.ph_lo = 0; a.ph_hi = NPHASES;
    hipLaunchKernelGGL(mk_fwd, dim3(grid), dim3(NTHREADS), LDS_BYTES, stream, a);
#endif
}
```

```cpp
#include <hip/hip_runtime.h>
#include <stdio.h>
#include <stdint.h>

#ifndef MK_DOUBLE
#define MK_DOUBLE -1
#endif
#ifndef MK_PER_PHASE
#define MK_PER_PHASE 0
#endif
static_assert(MK_PER_PHASE == 0, "phases 5 and 9 synchronise inside the launch: build the one-launch form");

#define LAS __attribute__((address_space(3)))
typedef unsigned short bf16_t;
typedef short bf16x8 __attribute__((ext_vector_type(8)));
typedef float f32x4 __attribute__((ext_vector_type(4)));
typedef float f32x2 __attribute__((ext_vector_type(2)));
typedef unsigned u32x4 __attribute__((ext_vector_type(4)));
typedef unsigned u32x2 __attribute__((ext_vector_type(2)));

constexpr int DM = 4096, SEQ = 4096, NBATCH = 4, NTOK = NBATCH * SEQ;
constexpr int NE = 32, DFF = 512, CAP = 16384;
constexpr float RMS_EPS = 1e-5f;
constexpr int NTHREADS = 512, NPHASES = 11;

constexpr size_t MiB = 1ull << 20;
constexpr size_t WS_CTL = 0;
constexpr size_t CTL_BYTES = 65536;
constexpr size_t CTL_CNT = 16384;
constexpr size_t WS_RSTD1 = 65536;
constexpr size_t WS_ROWTOK = 1 * MiB;
constexpr size_t WS_ROWRSTD = 3 * MiB;
constexpr size_t WS_ROWGATE = 5 * MiB;
constexpr size_t WS_ROWDST = 7 * MiB;
constexpr size_t WS_PWT = 9 * MiB;
constexpr size_t WS_FWT = 11 * MiB;
constexpr size_t WS_DFTC = 13 * MiB;
constexpr size_t WS_GT = 14 * MiB;
constexpr size_t WS_RWT = 18 * MiB;
constexpr size_t WS_WGU = 20 * MiB;
constexpr size_t WS_WD = 148 * MiB;
constexpr size_t WS_H1B = 212 * MiB;
constexpr size_t WS_H1F8 = 340 * MiB;
constexpr size_t WS_ACT = 404 * MiB;
constexpr size_t WS_TABG = 437 * MiB;
constexpr size_t WS_E = 440 * MiB;
constexpr size_t E_XB = WS_E;
constexpr size_t E_MIXED = WS_E + 512 * MiB;
constexpr size_t E_WINT = WS_E + 128 * MiB;
constexpr size_t E_HM = E_WINT;
constexpr size_t E_WOUTT = WS_E + 160 * MiB;
constexpr size_t E_U = WS_E + 192 * MiB;
constexpr size_t E_VEVO = WS_E + 320 * MiB;
constexpr size_t E_QT = WS_E + 448 * MiB;
constexpr size_t E_T = E_U;
constexpr size_t E_WINP = E_QT;
constexpr size_t E_Y = WS_E;
constexpr size_t WS_END = WS_E + 640 * MiB;

constexpr int LDS_STAGE = 131072;
constexpr int LX_BAR = LDS_STAGE;
constexpr int LX_TAB = LDS_STAGE + 256;
constexpr int LX_RT = LDS_STAGE + 4096;
constexpr int LDS_BYTES = LDS_STAGE + 16384;

__device__ __forceinline__ unsigned cvt_pk_bf16(float lo, float hi) { unsigned r; asm("v_cvt_pk_bf16_f32 %0, %1, %2" : "=v"(r) : "v"(lo), "v"(hi)); return r; }
__device__ __forceinline__ float bf_lo(unsigned w) { return __uint_as_float(w << 16); }
__device__ __forceinline__ float bf_hi(unsigned w) { return __uint_as_float(w & 0xffff0000u); }
__device__ __forceinline__ u32x4 pack8(const f32x4 a, const f32x4 b) { u32x4 w; w.x = cvt_pk_bf16(a[0], a[1]); w.y = cvt_pk_bf16(a[2], a[3]); w.z = cvt_pk_bf16(b[0], b[1]); w.w = cvt_pk_bf16(b[2], b[3]); return w; }
__device__ __forceinline__ float wave_sum(float v) {
#pragma unroll
    for (int o = 32; o >= 1; o >>= 1) v += __shfl_xor(v, o);
    return v;
}

#define XB_TMO      128
#define XB_XCNT(j)  (256  + 64 * (j))
#define XB_XSUB(j)  (1280 + 64 * (j))
#define XB_XGEN(j)  (2304 + 64 * (j))
#define XB_TOP      3328
#define XB_TOPGEN   3392
#define XCD_BAR_WORDS 3456
#define XB_SPIN_CAP (1u << 18)
__device__ __forceinline__ unsigned xb_ld(unsigned* p)              { return __hip_atomic_load(p, __ATOMIC_RELAXED, __HIP_MEMORY_SCOPE_AGENT); }
__device__ __forceinline__ unsigned xb_add(unsigned* p, unsigned v) { return __hip_atomic_fetch_add(p, v, __ATOMIC_RELAXED, __HIP_MEMORY_SCOPE_AGENT); }
__device__ __forceinline__ unsigned xb_xcc_id() { return (unsigned)__builtin_amdgcn_s_getreg((3 << 11) | 20) & 0xFu; }
#define XB_SPIN(cond, bar) do { unsigned _sp = 0; while (cond) { __builtin_amdgcn_s_sleep(1); \
    if ((++_sp & 255u) == 0u) { if (xb_ld(&(bar)[XB_TMO])) break; if (_sp > XB_SPIN_CAP) { atomicAdd(&(bar)[XB_TMO], 1u); break; } } } } while (0)
struct XcdBarrier { unsigned* bar; unsigned x; volatile LAS unsigned* st; };
__device__ __forceinline__ XcdBarrier xcd_barrier_post(unsigned* bar, volatile LAS unsigned* st) {
    XcdBarrier b; b.bar = bar; b.x = xb_xcc_id(); b.st = st;
    if (threadIdx.x == 0) (void)xb_add(&bar[XB_XCNT(b.x)], 1u);
    return b;
}
__device__ __forceinline__ void xcd_barrier_complete(unsigned* bar, unsigned x, unsigned& nloc, unsigned& nx) {
    const unsigned G = gridDim.x * gridDim.y * gridDim.z;
    unsigned sum, cnt, mine, sp = 0u;
    for (;;) {
        sum = 0u; cnt = 0u; mine = 0u;
#pragma unroll
        for (unsigned j = 0; j < 16; ++j) { const unsigned c = xb_ld(&bar[XB_XCNT(j)]); sum += c; cnt += (c > 0u) ? 1u : 0u; mine = (j == x) ? c : mine; }
        if (sum == G) break;
        __builtin_amdgcn_s_sleep(1);
        if ((++sp & 255u) == 0u) { if (xb_ld(&bar[XB_TMO])) break; if (sp > XB_SPIN_CAP) { atomicAdd(&bar[XB_TMO], 1u); break; } }
    }
    nloc = mine > 0u ? mine : 1u; nx = cnt > 0u ? cnt : 1u;
}
__device__ __forceinline__ void xcd_barrier(const XcdBarrier& b, const bool leader) {
    asm volatile("s_waitcnt vmcnt(0)" ::: "memory");
    __syncthreads();
    if (leader) {
        unsigned* bar = b.bar;
        __builtin_amdgcn_s_waitcnt(0);
        unsigned nloc = b.st[0], nx = b.st[1];
        if (nloc == 0u) { xcd_barrier_complete(bar, b.x, nloc, nx); b.st[0] = nloc; b.st[1] = nx; }
        const unsigned old = xb_add(&bar[XB_XSUB(b.x)], 1u);
        const unsigned gen = old / nloc;
        if (old + 1u == (gen + 1u) * nloc) {
            __builtin_amdgcn_fence(__ATOMIC_RELEASE, "agent");
            asm volatile("s_waitcnt vmcnt(0)" ::: "memory");
            const unsigned og = xb_add(&bar[XB_TOP], 1u);
            const unsigned tg = og / nx;
            if (og + 1u == (tg + 1u) * nx) xb_add(&bar[XB_TOPGEN], 1u);
            else XB_SPIN(xb_ld(&bar[XB_TOPGEN]) == tg, bar);
            __builtin_amdgcn_fence(__ATOMIC_ACQUIRE, "agent");
            xb_add(&bar[XB_XGEN(b.x)], 1u);
            asm volatile("s_waitcnt vmcnt(0)" ::: "memory");
        } else {
            XB_SPIN(xb_ld(&bar[XB_XGEN(b.x)]) == gen, bar);
            __builtin_amdgcn_fence(__ATOMIC_ACQUIRE, "agent");
            asm volatile("s_waitcnt vmcnt(0)" ::: "memory");
        }
    }
    __syncthreads();
}

namespace g8 {
constexpr int BM = 256, BK = 64, HALF = 128, HTB = HALF * BK * 2, NXCD = 8, WGM = 8;
__device__ __forceinline__ int lds_byte(int r, int c) { const int st = (r >> 4) * 2 + (c >> 5), rr = r & 15, cc = c & 31, ob = rr * 64 + cc * 2; return st * 1024 + (ob ^ (((ob >> 9) & 1) << 5)); }
__device__ __forceinline__ void stage_rc(int b, int& R, int& C) { const int st = b / 1024, sb = b % 1024, swz = sb ^ (((sb >> 9) & 1) << 5); R = (st >> 1) * 16 + swz / 64; C = (st & 1) * 32 + (swz % 64) / 2; }
__device__ __forceinline__ int perm32(int rho) { const int n = rho >> 4, i = rho & 15; return 8 * (i >> 2) + 4 * n + (i & 3); }

struct Unit { int pm, pn, e, mt, cnt, rb; };

__device__ __forceinline__ bool tile_of_L(long L, int nM, int nN, int& pm, int& pn) {
    const int nwg = nM * nN; if (L >= nwg) return false;
    int wgid = (int)L; { const int q = nwg / NXCD, r = nwg % NXCD, xcd = wgid % NXCD, off = wgid / NXCD; wgid = (xcd < r ? xcd * (q + 1) : r * (q + 1) + (xcd - r) * q) + off; }
    const int nig = WGM * nN, gid = wgid / nig, fm = gid * WGM, gsz = (nM - fm) < WGM ? (nM - fm) : WGM;
    pm = fm + ((wgid % nig) % gsz); pn = (wgid % nig) / gsz; return true;
}
__device__ __forceinline__ bool static_tile(int i, int G, int c, int nM, int nN, int& pm, int& pn) { return tile_of_L((long)i * G + c, nM, nN, pm, pn); }

typedef f32x4 Acc[2][2][4][2];
__device__ __forceinline__ int lane_id_v() { int l; asm volatile("v_mbcnt_lo_u32_b32 %0, -1, 0\n\tv_mbcnt_hi_u32_b32 %0, -1, %0" : "=&v"(l)); return l; }
typedef int i32x8 __attribute__((ext_vector_type(8)));
typedef int i32x4 __attribute__((ext_vector_type(4)));
__device__ __forceinline__ i32x8 cat8(bf16x8 a, bf16x8 b) { const i32x4 x = __builtin_bit_cast(i32x4, a), y = __builtin_bit_cast(i32x4, b); return __builtin_shufflevector(x, y, 0, 1, 2, 3, 4, 5, 6, 7); }
__device__ __forceinline__ u32x2 pack8_fp8(const f32x4 a, const f32x4 b) { int w0 = 0, w1 = 0;
    w0 = __builtin_amdgcn_cvt_pk_fp8_f32(a[0], a[1], w0, false); w0 = __builtin_amdgcn_cvt_pk_fp8_f32(a[2], a[3], w0, true);
    w1 = __builtin_amdgcn_cvt_pk_fp8_f32(b[0], b[1], w1, false); w1 = __builtin_amdgcn_cvt_pk_fp8_f32(b[2], b[3], w1, true);
    u32x2 r; r.x = (unsigned)w0; r.y = (unsigned)w1; return r; }

template <int N> __device__ __forceinline__ void wait_vm() { static_assert(N >= 0 && N < 64, "vmcnt is a 6-bit counter"); asm volatile("s_waitcnt vmcnt(%0)" :: "n"(N) : "memory"); }
template <class P>
__device__ __forceinline__ void gemm_phase(LAS unsigned char* lds, const P& p, const int wid) {
    constexpr int SX = P::STREAM != 0 ? 2 : 0;
    const int lane = (int)__builtin_amdgcn_mbcnt_hi(~0u, __builtin_amdgcn_mbcnt_lo(~0u, 0u)), tid = wid * 64 + lane, wr = wid >> 2, wc = wid & 3, fr = lane & 15, fq = lane >> 4;
    const int nt = p.nt;
    int Rr0, Cc0; stage_rc(tid * 16, Rr0, Cc0);
    const unsigned voffA = (unsigned)Rr0 * p.lda2 + (unsigned)Cc0 * 2u, voffB = (unsigned)(64 * (Rr0 >> 5) + 16 * ((Rr0 & 15) >> 2) + 4 * ((Rr0 >> 4) & 1) + (Rr0 & 3)) * p.ldb2 + (unsigned)Cc0 * 2u;
    const unsigned pstepA = 64u * p.lda2, pstepB = 128u * p.ldb2;
    const unsigned kstep = (unsigned)(BK * 2);
    const unsigned hstepA = (unsigned)HALF * p.lda2, hstepB = 8u * p.ldb2;
    const unsigned ldsw = ((unsigned)wid * 1024u) & 0x1c00u;
    const int aoff = lds_byte(wr * 64 + fr, fq * 8) & 0x3ff0, boff = lds_byte(wc * 32 + fr, fq * 8) & 0x3ff0;
    unsigned abase = (unsigned)(size_t)lds + (unsigned)aoff, bbase = (unsigned)(size_t)lds + 65536u + (unsigned)boff;
    int scale1 = 0x7f7f7f7f; asm volatile("" : "+v"(scale1));
    unsigned cvA[2][2], nvA[2][2];
    const __amdgpu_buffer_rsrc_t rsA = __builtin_amdgcn_make_buffer_rsrc((void*)p.A, (short)0, (int)0xFFFFFF00u, 0x00020000);
    const __amdgpu_buffer_rsrc_t rsB = __builtin_amdgcn_make_buffer_rsrc((void*)p.B, (short)0, (int)0xFFFFFF00u, 0x00020000);
#define G8_SA(b, h) (((b) * 2 + (h)) * HTB)
#define G8_SB(b, h) ((4 + (b) * 2 + (h)) * HTB)
#define G8_STAGE_B(bufoff, soff, h) do { const unsigned _so = (unsigned)(soff) + (unsigned)(h) * hstepB; _Pragma("unroll") for (int _i = 0; _i < 2; ++_i) \
        __builtin_amdgcn_raw_ptr_buffer_load_lds(rsB, (LAS void*)(lds + (bufoff) + ldsw + _i * 8192), 16, (int)voffB, (int)(_so + _i * pstepB), 0, 0); } while (0)
#define G8_STAGE_A(bufoff, soff, h, NX) do { \
        if constexpr (P::GATHER) { _Pragma("unroll") for (int _i = 0; _i < 2; ++_i) { const unsigned _o = (NX) ? nvA[h][_i] : cvA[h][_i]; \
            __builtin_amdgcn_raw_ptr_buffer_load_lds(rsA, (LAS void*)(lds + (bufoff) + ldsw + _i * 8192), 16, (int)_o, (int)(unsigned)(soff), 0, 0); } } \
        else { const unsigned _so = (unsigned)(soff) + (unsigned)(h) * hstepA; _Pragma("unroll") for (int _i = 0; _i < 2; ++_i) \
            __builtin_amdgcn_raw_ptr_buffer_load_lds(rsA, (LAS void*)(lds + (bufoff) + ldsw + _i * 8192), 16, (int)voffA, (int)(_so + _i * pstepA), 0, 0); } } while (0)
#define G8_FA(b, h, m, k) (*(const LAS bf16x8*)(lds + aoff + (G8_SA(b, h) + (m) * 2048 + (k) * 1024)))
#define G8_FB(b, h, n, k) (*(const LAS bf16x8*)(lds + boff + (G8_SB(b, h) + (n) * 2048 + (k) * 1024)))
#define G8_RD(dst, base, off) asm volatile("ds_read_b128 %0, %1 offset:%2" : "=v"(dst) : "v"(base), "i"(off))
#define G8_LDA(dst, b, h) do { _Pragma("unroll") for (int m = 0; m < 4; ++m) _Pragma("unroll") for (int k = 0; k < 2; ++k) { \
        if constexpr (P::FP8) G8_RD(dst[m][k], abase, G8_SA(b, h) + m * 2048 + k * 1024); else dst[m][k] = G8_FA(b, h, m, k); } } while (0)
#define G8_LDB(dst, b, h) do { _Pragma("unroll") for (int n = 0; n < 2; ++n) _Pragma("unroll") for (int k = 0; k < 2; ++k) { \
        if constexpr (P::FP8) G8_RD(dst[n][k], bbase, G8_SB(b, h) - 65536 + n * 2048 + k * 1024); else dst[n][k] = G8_FB(b, h, n, k); } } while (0)
#define G8_WAIT_L_AB() do { if constexpr (P::FP8) asm volatile("s_waitcnt lgkmcnt(0)" : "+v"(B0[0][0]), "+v"(B0[0][1]), "+v"(B0[1][0]), "+v"(B0[1][1]), "+v"(B1[0][0]), "+v"(B1[0][1]), "+v"(B1[1][0]), "+v"(B1[1][1]), \
            "+v"(At[0][0]), "+v"(At[0][1]), "+v"(At[1][0]), "+v"(At[1][1]), "+v"(At[2][0]), "+v"(At[2][1]), "+v"(At[3][0]), "+v"(At[3][1])); else G8_WAIT_L(0); } while (0)
#define G8_WAIT_L_A() do { if constexpr (P::FP8) asm volatile("s_waitcnt lgkmcnt(0)" : "+v"(At[0][0]), "+v"(At[0][1]), "+v"(At[1][0]), "+v"(At[1][1]), "+v"(At[2][0]), "+v"(At[2][1]), "+v"(At[3][0]), "+v"(At[3][1])); else G8_WAIT_L(0); } while (0)
#define G8_MMA(ai, bj, At, Bt) do { __builtin_amdgcn_s_setprio(1); _Pragma("unroll") for (int m = 0; m < 4; ++m) _Pragma("unroll") for (int n = 0; n < 2; ++n) { \
        if constexpr (P::FP8) asm volatile("v_mfma_scale_f32_16x16x128_f8f6f4 %0, %1, %2, %0, %3, %3 op_sel_hi:[0,0,0]" : "+v"(acc[ai][bj][m][n]) : "v"(cat8(Bt[n][0], Bt[n][1])), "v"(cat8(At[m][0], At[m][1])), "v"(scale1)); \
        else { _Pragma("unroll") for (int k = 0; k < 2; ++k) asm volatile("v_mfma_f32_16x16x32_bf16 %0, %1, %2, %0" : "+v"(acc[ai][bj][m][n]) : "v"(Bt[n][k]), "v"(At[m][k])); } } \
        __builtin_amdgcn_s_setprio(0); } while (0)
#define G8_MMA0(ai, bj, At, Bt) do { __builtin_amdgcn_s_setprio(1); _Pragma("unroll") for (int m = 0; m < 4; ++m) _Pragma("unroll") for (int n = 0; n < 2; ++n) { \
        if constexpr (P::FP8) asm volatile("v_mfma_scale_f32_16x16x128_f8f6f4 %0, %1, %2, 0, %3, %3 op_sel_hi:[0,0,0]" : "+v"(acc[ai][bj][m][n]) : "v"(cat8(Bt[n][0], Bt[n][1])), "v"(cat8(At[m][0], At[m][1])), "v"(scale1)); \
        else { asm volatile("v_mfma_f32_16x16x32_bf16 %0, %1, %2, 0" : "+v"(acc[ai][bj][m][n]) : "v"(Bt[n][0]), "v"(At[m][0])); \
               asm volatile("v_mfma_f32_16x16x32_bf16 %0, %1, %2, %0" : "+v"(acc[ai][bj][m][n]) : "v"(Bt[n][1]), "v"(At[m][1])); } } \
        __builtin_amdgcn_s_setprio(0); } while (0)
#define G8_MMAF(ai, bj, At, Bt, FIRST) do { if (FIRST) G8_MMA0(ai, bj, At, Bt); else G8_MMA(ai, bj, At, Bt); } while (0)
#define G8_WAIT_V(n) asm volatile("s_waitcnt vmcnt(" #n ")" ::: "memory")
#define G8_WAIT_L(n) asm volatile("s_waitcnt lgkmcnt(" #n ")" ::: "memory")
#define G8_BAR __builtin_amdgcn_s_barrier()
#define G8_SCHED __builtin_amdgcn_sched_barrier(0)
    Unit cur, nxt; int ui = 0;
    if (!p.next(0, cur)) return;
    int l2pf[1] = {0};
    unsigned strip = 0; int sacc[4] = {0, 0, 0, 0};
    Acc acc;
#pragma unroll
    for (int a = 0; a < 2; ++a)
#pragma unroll
        for (int b = 0; b < 2; ++b)
#pragma unroll
            for (int m = 0; m < 4; ++m)
#pragma unroll
                for (int n = 0; n < 2; ++n) acc[a][b][m][n] = (f32x4){0.f, 0.f, 0.f, 0.f};
    bf16x8 At[4][2], B0[2][2], B1[2][2];
    typename P::Pre pre;
    unsigned cA = __builtin_amdgcn_readfirstlane(p.a_off(cur)), cB = __builtin_amdgcn_readfirstlane(p.b_off(cur));
    if constexpr (P::GATHER) { p.a_rows(cur, wid, cvA); p.a_rows_fin(wid, cvA); asm volatile("" : "+v"(cvA[0][0]), "+v"(cvA[0][1]), "+v"(cvA[1][0]), "+v"(cvA[1][1])); }
    G8_STAGE_B(G8_SB(0, 0), cB, 0); G8_STAGE_B(G8_SB(0, 1), cB, 1); G8_STAGE_A(G8_SA(0, 0), cA, 0, false); G8_STAGE_A(G8_SA(0, 1), cA, 1, false);
    if (wr == 1) G8_BAR;
    G8_WAIT_V(2); G8_BAR;
    G8_STAGE_B(G8_SB(1, 0), cB + kstep, 0); G8_STAGE_A(G8_SA(1, 0), cA + kstep, 0, false); G8_STAGE_B(G8_SB(1, 1), cB + kstep, 1);
    G8_WAIT_V(6); G8_BAR;
    for (;;) {
        p.prefetch(cur, wid, pre);
        const bool has_next = p.next(ui + 1, nxt);
        const unsigned nA = __builtin_amdgcn_readfirstlane(has_next ? p.a_off(nxt) : cA), nB = __builtin_amdgcn_readfirstlane(has_next ? p.b_off(nxt) : cB);
        if constexpr (P::GATHER) { Unit ar; ar.pm = has_next ? nxt.pm : cur.pm; ar.pn = has_next ? nxt.pn : cur.pn; ar.e = has_next ? nxt.e : cur.e; ar.mt = has_next ? nxt.mt : cur.mt; ar.cnt = has_next ? nxt.cnt : cur.cnt; ar.rb = has_next ? nxt.rb : cur.rb;
            p.a_rows(ar, wid, nvA); }
#define G8_TRIP(TT, FIRST) do { \
            const int t = (TT); const bool last = (FIRST) ? false : (t == nt - 2);        \
            const unsigned a1 = cA + (unsigned)(t + 1) * kstep; \
            const unsigned a2 = last ? nA : cA + (unsigned)(t + 2) * kstep, b2 = last ? nB : cB + (unsigned)(t + 2) * kstep; \
            const unsigned a3 = a2 + kstep, b3 = b2 + kstep; \
            G8_LDB(B0, 0, 0); G8_LDB(B1, 0, 1); G8_SCHED; G8_LDA(At, 0, 0); G8_STAGE_A(G8_SA(1, 1), a1, 1, false); \
            f32x4 se0, se1; bool sval = false; int srq = 0, scc = 0, stI = 0; \
            if constexpr (P::STREAM != 0) { \
                const int sk = (int)(strip >> 2), sph = (int)(strip & 3u); \
                sval = sk < p.sk1; stI = sval ? p.sbid + sk * p.G : 0; \
                const int bi = wid * 2 + (sph >> 1); srq = (bi >> 2) * 8 + (lane >> 3); scc = (bi & 3) * 8 + (lane & 7); \
                const float* sp; int sld; \
                if constexpr (P::STREAM == 1) { const int q = stI & 4095, e = q >> 7, r = q & 127, kt = r >> 2, pn = r & 3; sld = 512; \
                    sp = (stI >= 4096 ? p.ssrc1 : p.ssrc0) + (size_t)e * 4096 * 512 + (size_t)kt * 128 * 512 + pn * 128; } \
                else { const int e = stI >> 7, r = stI & 127, ft = r >> 5, dt = r & 31; sld = 4096; \
                    sp = p.ssrc0 + (size_t)e * 512 * 4096 + (size_t)ft * 128 * 4096 + dt * 128; } \
                sp += (size_t)(4 * srq + 2 * (sph & 1)) * sld + scc * 4; \
                se0 = __builtin_nontemporal_load((const f32x4*)sp); se1 = __builtin_nontemporal_load((const f32x4*)(sp + sld)); \
            } \
            if (FIRST) { if (ui == 0) wait_vm<8 + SX + P::NPF>(); else wait_vm<8 + SX + P::NPF + P::NS>(); } else wait_vm<8 + SX>(); \
            G8_WAIT_L_AB(); G8_BAR; G8_MMAF(0, 0, At, B0, FIRST); G8_MMAF(0, 1, At, B1, FIRST); G8_BAR; G8_SCHED; \
            G8_LDA(At, 0, 1); G8_STAGE_B(G8_SB(0, 0), b2, 0); G8_STAGE_B(G8_SB(0, 1), b2, 1); G8_STAGE_A(G8_SA(0, 0), a2, 0, last); \
            if (FIRST) { if (ui == 0) wait_vm<8 + SX + P::NPF>(); else wait_vm<8 + SX + P::NPF + P::NS>(); } else wait_vm<8 + SX>(); \
            G8_WAIT_L_A(); G8_BAR; G8_MMAF(1, 0, At, B0, FIRST); G8_MMAF(1, 1, At, B1, FIRST); G8_BAR; G8_SCHED; \
            G8_LDB(B0, 1, 0); G8_LDB(B1, 1, 1); G8_SCHED; G8_LDA(At, 1, 0); G8_STAGE_A(G8_SA(0, 1), a2, 1, last); \
            wait_vm<8 + SX>(); \
            G8_WAIT_L_AB(); G8_BAR; G8_MMA(0, 0, At, B0); G8_MMA(0, 1, At, B1); G8_BAR; G8_SCHED; \
            G8_LDA(At, 1, 1); G8_STAGE_B(G8_SB(1, 0), b3, 0); G8_STAGE_B(G8_SB(1, 1), b3, 1); G8_STAGE_A(G8_SA(1, 0), a3, 0, last); \
            wait_vm<8>(); G8_WAIT_L_A(); G8_BAR; G8_MMA(1, 0, At, B0); G8_MMA(1, 1, At, B1); G8_BAR; G8_SCHED; \
            if constexpr (P::STREAM != 0) { \
                if ((strip & 1u) == 0) { \
                    _Pragma("unroll") for (int j = 0; j < 4; ++j) sacc[j] = __builtin_amdgcn_cvt_pk_fp8_f32(se0[j] * 64.f, se1[j] * 64.f, sacc[j], false); \
                } else { \
                    _Pragma("unroll") for (int j = 0; j < 4; ++j) sacc[j] = __builtin_amdgcn_cvt_pk_fp8_f32(se0[j] * 64.f, se1[j] * 64.f, sacc[j], true); \
                    if (sval) { \
                        unsigned char* dp; int dld; \
                        if constexpr (P::STREAM == 1) { const int q = stI & 4095, e = q >> 7, r = q & 127, kt = r >> 2, pn = r & 3; dld = 4096; \
                            dp = p.sdst + ((size_t)e * 1024 + pn * 256 + (stI >= 4096 ? 8 : 0) + 16 * (scc >> 1) + 4 * (scc & 1)) * 4096 + kt * 128 + 4 * srq; } \
                        else if constexpr (P::STREAM == 2) { const int e = stI >> 7, r = stI & 127, ft = r >> 5, dt = r & 31; dld = 512; \
                            dp = p.sdst + ((size_t)e * 4096 + dt * 128 + 4 * scc) * 512 + ft * 128 + 4 * srq; } \
                        else { const int kt = stI >> 5, nn = stI & 31; dld = 4096; \
                            dp = p.sdst + ((size_t)nn * 128 + 4 * scc) * 4096 + kt * 128 + 4 * srq; } \
                        _Pragma("unroll") for (int j = 0; j < 4; ++j) *(int*)(dp + (size_t)j * dld) = sacc[j]; \
                    } \
                } \
                ++strip; \
            } } while (0)
        G8_TRIP(0, true);
        if constexpr (P::L2PF) asm volatile("" :: "v"(l2pf[0]));
        if constexpr (P::GATHER) { asm volatile("" : "+v"(nvA[0][0]), "+v"(nvA[0][1]), "+v"(nvA[1][0]), "+v"(nvA[1][1])); p.a_rows_fin(wid, nvA); }
        for (int tq = 2; tq < nt; tq += 2) G8_TRIP(tq, false);
#undef G8_TRIP
        if (wr == 0) G8_BAR;
        if constexpr (P::L2PF) p.l2_prefetch(has_next, cur, nxt, ui, wid, l2pf);
        asm volatile("s_nop 15\n\ts_nop 15" ::: "memory");
        { const int lz = lane_id_v(); p.epi(acc, cur, wid >> 2, wid & 3, lz & 15, lz >> 4, pre); }
        if (!has_next) break;
        cur = nxt; cA = nA; cB = nB; ++ui;
        if constexpr (P::GATHER) { cvA[0][0] = nvA[0][0]; cvA[0][1] = nvA[0][1]; cvA[1][0] = nvA[1][0]; cvA[1][1] = nvA[1][1]; }
        if (wr == 1) G8_BAR;
    }
    G8_WAIT_V(0);
    G8_BAR;
#undef G8_SA
#undef G8_SB
#undef G8_STAGE_A
#undef G8_STAGE_B
#undef G8_LDA
#undef G8_FA
#undef G8_FB
#undef G8_RD
#undef G8_WAIT_L_AB
#undef G8_WAIT_L_A
#undef G8_LDB
#undef G8_MMA
#undef G8_MMA0
#undef G8_MMAF
#undef G8_WAIT_V
#undef G8_WAIT_L
#undef G8_BAR
#undef G8_SCHED
}

template <int EPI  , bool F8 = false, int STRM = 0> struct DenseP {
    static constexpr bool GATHER = false, FP8 = F8; static constexpr int SCALE_B = 0x7f7f7f7f;
    static constexpr bool L2PF = false; __device__ __forceinline__ void l2_prefetch(bool, const Unit&, const Unit&, int, int, int (&)[1]) const {}
    static constexpr int NPF = 0, NS = (EPI == 0 ? 16 : EPI == 1 ? 24 : 44);
    static constexpr int STREAM = STRM;
    const float* ssrc0; const float* ssrc1; unsigned char* sdst; int sbid, sk1; int pad2_[2];
    const char* A; const char* B; bf16_t* C; unsigned char* C8;
    unsigned lda2, ldb2; int nt, nM, nN, G, c, mPer, bDiv, ldc; float oscale; int pad_;
    size_t aHi, aLo, bHi, bLo, cHi, cLo;
    const float* rowscale; const float* resid; const bf16_t* residb;
    __device__ __forceinline__ bool next(int i, Unit& u) const { u.e = 0; u.mt = 0; u.cnt = 0; u.rb = 0; return static_tile(i, G, c, nM, nN, u.pm, u.pn); }
    __device__ __forceinline__ unsigned a_off(const Unit& u) const { const int batch = u.pm / mPer, mt = u.pm % mPer; return (unsigned)((size_t)(batch / bDiv) * aHi + (size_t)(batch % bDiv) * aLo + (size_t)mt * 256 * lda2); }
    __device__ __forceinline__ unsigned b_off(const Unit& u) const { const int batch = u.pm / mPer; return (unsigned)((size_t)(batch / bDiv) * bHi + (size_t)(batch % bDiv) * bLo + (size_t)u.pn * 256 * ldb2); }
    struct Pre {};
    __device__ __forceinline__ void prefetch(const Unit&, int, Pre&) const {}
    __device__ __forceinline__ void a_rows(const Unit&, int, unsigned (&)[2][2]) const {}
    __device__ __forceinline__ void a_rows_fin(int, unsigned (&)[2][2]) const {}
    __device__ __forceinline__ void epi(const Acc& acc, const Unit& u, int wr, int wc, int fr, int fq, const Pre&) const {
        const int batch = u.pm / mPer, mt = u.pm % mPer;
        const int row0 = mt * 256 + wr * 64 + fr, col0 = u.pn * 256 + wc * 64 + 16 * fq;
        bf16_t* base = C + (size_t)(batch / bDiv) * cHi + (size_t)(batch % bDiv) * cLo;
        float rsv[2][4];
#pragma unroll
        for (int ai = 0; ai < 2; ++ai)
#pragma unroll
            for (int m = 0; m < 4; ++m) rsv[ai][m] = (EPI == 1) ? rowscale[row0 + ai * 128 + m * 16] : 1.f;
        if constexpr (EPI == 2) {
            f32x4 cs8[2][2];
#pragma unroll
            for (int bj = 0; bj < 2; ++bj) { cs8[bj][0] = *(const f32x4*)(rowscale + col0 + bj * 8); cs8[bj][1] = *(const f32x4*)(rowscale + col0 + bj * 8 + 4); }
#pragma unroll
            for (int ai = 0; ai < 2; ++ai) {
                u32x4 rv[4][2];
#pragma unroll
                for (int m = 0; m < 4; ++m)
#pragma unroll
                    for (int bj = 0; bj < 2; ++bj) rv[m][bj] = *(const u32x4*)(residb + (size_t)(row0 + ai * 128 + m * 16) * ldc + col0 + bj * 8);
                __builtin_amdgcn_sched_barrier(0);
#pragma unroll
                for (int m = 0; m < 4; ++m) {
                    const int row = row0 + ai * 128 + m * 16;
                    u32x2 f8[2];
#pragma unroll
                    for (int bj = 0; bj < 2; ++bj) {
                        const u32x4 rw = rv[m][bj];
                        const f32x4 v0 = acc[ai][bj][m][0] * oscale + (f32x4){bf_lo(rw.x), bf_hi(rw.x), bf_lo(rw.y), bf_hi(rw.y)}, v1 = acc[ai][bj][m][1] * oscale + (f32x4){bf_lo(rw.z), bf_hi(rw.z), bf_lo(rw.w), bf_hi(rw.w)};
                        *(u32x4*)(base + (size_t)row * ldc + col0 + bj * 8) = pack8(v0, v1);
                        f8[bj] = pack8_fp8(v0 * cs8[bj][0], v1 * cs8[bj][1]);
                    }
                    *(u32x4*)(C8 + (size_t)row * ldc + col0) = (u32x4){f8[0].x, f8[0].y, f8[1].x, f8[1].y};
                }
                __builtin_amdgcn_sched_barrier(0);
            }
        } else {
#pragma unroll
        for (int ai = 0; ai < 2; ++ai)
#pragma unroll
            for (int m = 0; m < 4; ++m) {
                const int row = row0 + ai * 128 + m * 16;
                const float rs = rsv[ai][m];
#pragma unroll
                for (int bj = 0; bj < 2; ++bj) {
                    f32x4 v0 = acc[ai][bj][m][0], v1 = acc[ai][bj][m][1];
                    if (EPI == 1) { v0 *= rs; v1 *= rs; }
                    *(u32x4*)(base + (size_t)row * ldc + col0 + bj * 8) = pack8(v0, v1);
                }
            }
        }
    }
};

#define TABU(x) __builtin_amdgcn_readfirstlane(x)
__device__ __forceinline__ void moe_rec(const int* tab, Unit& u) {
    const i32x4 r = *(const i32x4*)(tab + 4 + 4 * u.pm);
    u.e = TABU(r.x); u.mt = TABU(r.y); u.cnt = TABU(r.z); u.rb = TABU(r.w); }
struct MoeGateUpP {
    static constexpr bool GATHER = true, FP8 = true; static constexpr int SCALE_B = 0x7f7f7f7f, STREAM = 0, NPF = 12  , NS = 12  ;
    static constexpr bool L2PF = false; __device__ __forceinline__ void l2_prefetch(bool, const Unit&, const Unit&, int, int, int (&)[1]) const {}
    const char* A; const char* B; unsigned lda2, ldb2; int nt, G, c;
    const int* tab; int m0, nMv;
    const int* rowtok; const float* rowrstd; const float* bgate; const float* bup; unsigned char* act;
    i32x4 lrec; int lpp;
    __device__ __forceinline__ bool unit_tile(int i, int& pm, int& pn) const { if (!static_tile(i, G, c, nMv, 4, pm, pn)) return false; pm += m0; return true; }
    __device__ __forceinline__ void preload() { const int lz = lane_id_v(); int pm, pn; lrec = (i32x4){0, 0, 0, 0}; lpp = -1;
        if (unit_tile(lz, pm, pn)) { lrec = *(const i32x4*)(tab + 4 + 4 * pm); lpp = pm | (pn << 16); } }
    __device__ __forceinline__ bool next(int i, Unit& u) const {
        if (i < 64) { const int pp = __builtin_amdgcn_readlane(lpp, i); if (pp < 0) return false; u.pm = pp & 0xffff; u.pn = pp >> 16;
            u.e = __builtin_amdgcn_readlane(lrec.x, i); u.mt = __builtin_amdgcn_readlane(lrec.y, i); u.cnt = __builtin_amdgcn_readlane(lrec.z, i); u.rb = __builtin_amdgcn_readlane(lrec.w, i); return true; }
        if (!unit_tile(i, u.pm, u.pn)) return false; moe_rec(tab, u); return true; }
    __device__ __forceinline__ unsigned a_off(const Unit&) const { return 0u; }
    __device__ __forceinline__ unsigned b_off(const Unit& u) const { return (unsigned)(((size_t)u.e * 1024 + (size_t)u.pn * 256) * ldb2); }
    __device__ __forceinline__ void a_rows(const Unit& u, int wid, unsigned (&v)[2][2]) const {
        const int cnt = u.cnt;
        const int tz = wid * 64 + lane_id_v(); int Rr[2], Cc[2]; stage_rc(tz * 16, Rr[0], Cc[0]); stage_rc(tz * 16 + 8192, Rr[1], Cc[1]);
#pragma unroll
        for (int h = 0; h < 2; ++h)
#pragma unroll
            for (int i = 0; i < 2; ++i) { const int pos = min(u.mt * 256 + h * 128 + Rr[i], cnt - 1); v[h][i] = (unsigned)rowtok[u.e * CAP + pos]; }
    }
    __device__ __forceinline__ void a_rows_fin(int wid, unsigned (&v)[2][2]) const {
        const int tz = wid * 64 + lane_id_v(); int Rr[2], Cc[2]; stage_rc(tz * 16, Rr[0], Cc[0]); stage_rc(tz * 16 + 8192, Rr[1], Cc[1]);
#pragma unroll
        for (int h = 0; h < 2; ++h)
#pragma unroll
            for (int i = 0; i < 2; ++i) v[h][i] = v[h][i] * lda2 + (unsigned)Cc[i] * 2u;
    }
    struct Pre { float rs[2][4]; };
    __device__ __forceinline__ void prefetch(const Unit& u, int wid, Pre& q) const {
        const int lz = lane_id_v(), wr = wid >> 2, fr = lz & 15;
#pragma unroll
        for (int ai = 0; ai < 2; ++ai)
#pragma unroll
            for (int m = 0; m < 4; ++m) { const int pos = min(u.mt * 256 + ai * 128 + wr * 64 + m * 16 + fr, u.cnt - 1); q.rs[ai][m] = rowrstd[u.e * CAP + pos]; }
    }
    __device__ __forceinline__ void epi(const Acc& acc, const Unit& u, int wr, int wc, int fr, int fq, const Pre& q) const {
        const int cnt = u.cnt, rb = u.rb;
        const int f0 = u.pn * 128 + wc * 32 + 8 * fq;
        const f32x4 bg0 = *(const f32x4*)(bgate + u.e * DFF + f0), bg1 = *(const f32x4*)(bgate + u.e * DFF + f0 + 4);
        const f32x4 bu0 = *(const f32x4*)(bup + u.e * DFF + f0), bu1 = *(const f32x4*)(bup + u.e * DFF + f0 + 4);
        float rsv[2][4];
#pragma unroll
        for (int ai = 0; ai < 2; ++ai)
#pragma unroll
            for (int m = 0; m < 4; ++m) rsv[ai][m] = q.rs[ai][m] * (1.0f / 64.0f);
        asm volatile("" :: "v"(rsv[0][0]), "v"(rsv[0][1]), "v"(rsv[0][2]), "v"(rsv[0][3]), "v"(rsv[1][0]), "v"(rsv[1][1]), "v"(rsv[1][2]), "v"(rsv[1][3]), "v"(bg0), "v"(bg1), "v"(bu0), "v"(bu1));
#pragma unroll
        for (int ai = 0; ai < 2; ++ai)
#pragma unroll
            for (int m = 0; m < 4; ++m) {
                const int pos = u.mt * 256 + ai * 128 + wr * 64 + m * 16 + fr;
                {
                    const float rs = rsv[ai][m];
                    f32x4 o[2];
#pragma unroll
                    for (int n = 0; n < 2; ++n) {
                        const f32x4 g = acc[ai][0][m][n] * rs + (n ? bg1 : bg0), up = acc[ai][1][m][n] * rs + (n ? bu1 : bu0);
#pragma unroll
                        for (int j = 0; j < 4; ++j) {
                            const float hg = fminf(g[j], 7.0f), hu = fminf(fmaxf(up[j], -7.0f), 7.0f);
                            const float sg = __builtin_amdgcn_rcpf(1.0f + __builtin_amdgcn_exp2f(-1.702f * 1.44269504f * hg));
                            o[n][j] = hg * sg * (hu + 1.0f);
                        }
                    }
                    *(u32x2*)(act + (size_t)(pos < cnt ? rb + pos : NTOK * 4) * DFF + f0) = pack8_fp8(o[0], o[1]);
                }
            }
    }
};
struct MoeDownP {
    static constexpr bool GATHER = false, FP8 = true; static constexpr int SCALE_B = 0x7f7f7f7f, STREAM = 0, NPF = 20  , NS = 9  ;
    static constexpr bool L2PF = true;
    const char* A; const char* B; unsigned lda2, ldb2; int nt, G, c;
    const int* tab; int mode, nbusy, m0, nMv;
    const int* rowdst; const float* rowgate; const float* bdown; unsigned char* y;
    i32x4 lrec; int lpp;
    __device__ __forceinline__ bool unit_tile(int i, int& pm, int& pn) const {
        if (mode == 1) { if (!static_tile(i, G, c, nMv, 16, pm, pn)) return false; pm += m0; }
        else { const int nfree = G - nbusy; long idx;
            if (c >= nbusy) idx = (i < 4) ? (long)i * nfree + (c - nbusy) : 4l * nfree + (long)(i - 4) * G + c;
            else idx = 4l * nfree + (long)i * G + c;
            if (!tile_of_L(idx, nMv, 16, pm, pn)) return false; }
        return true; }
    __device__ __forceinline__ void preload() { const int lz = lane_id_v(); int pm, pn; lrec = (i32x4){0, 0, 0, 0}; lpp = -1;
        if (unit_tile(lz, pm, pn)) { lrec = *(const i32x4*)(tab + 4 + 4 * pm); lpp = pm | (pn << 16); } }
    __device__ __forceinline__ bool next(int i, Unit& u) const {
        if (i < 64) { const int pp = __builtin_amdgcn_readlane(lpp, i); if (pp < 0) return false; u.pm = pp & 0xffff; u.pn = pp >> 16;
            u.e = __builtin_amdgcn_readlane(lrec.x, i); u.mt = __builtin_amdgcn_readlane(lrec.y, i); u.cnt = __builtin_amdgcn_readlane(lrec.z, i); u.rb = __builtin_amdgcn_readlane(lrec.w, i); return true; }
        if (!unit_tile(i, u.pm, u.pn)) return false; moe_rec(tab, u); return true; }
    __device__ __forceinline__ unsigned a_off(const Unit& u) const { return (unsigned)((size_t)(u.rb + u.mt * 256) * lda2); }
    __device__ __forceinline__ void l2_prefetch(bool has_next, const Unit& cur, const Unit& nxt, int, int wid, int (&v)[1]) const {
        const int e1 = has_next ? nxt.e : cur.e, pn1 = has_next ? nxt.pn : cur.pn;
        const int tz = wid * 64 + lane_id_v(); const unsigned ro = (unsigned)(tz >> 1) * 512u + (unsigned)(tz & 1) * 128u + 256u;
        const char* b1 = B + ((size_t)((size_t)e1 * 4096 + (size_t)pn1 * 256) * ldb2 + ro);
        asm volatile("global_load_dword %0, %1, off" : "=v"(v[0]) : "v"(b1) : "memory");
    }
    __device__ __forceinline__ unsigned b_off(const Unit& u) const { return (unsigned)(((size_t)u.e * 4096 + (size_t)u.pn * 256) * ldb2); }
    __device__ __forceinline__ void a_rows(const Unit&, int, unsigned (&)[2][2]) const {}
    __device__ __forceinline__ void a_rows_fin(int, unsigned (&)[2][2]) const {}
    struct Pre { float gw[2][4]; int ds[2][4]; f32x4 bd[2][2]; };
    __device__ __forceinline__ void prefetch(const Unit& u, int wid, Pre& q) const {
        const int lz = lane_id_v(), wr = wid >> 2, fr = lz & 15;
        {   const int c0 = u.pn * 256 + (wid & 3) * 64 + 16 * (lz >> 4);
#pragma unroll
            for (int bj = 0; bj < 2; ++bj) { q.bd[bj][0] = *(const f32x4*)(bdown + (size_t)u.e * DM + c0 + bj * 8); q.bd[bj][1] = *(const f32x4*)(bdown + (size_t)u.e * DM + c0 + bj * 8 + 4); } }
#pragma unroll
        for (int ai = 0; ai < 2; ++ai)
#pragma unroll
            for (int m = 0; m < 4; ++m) { const int pos = min(u.mt * 256 + ai * 128 + wr * 64 + m * 16 + fr, u.cnt - 1); q.gw[ai][m] = rowgate[u.e * CAP + pos]; q.ds[ai][m] = rowdst[u.e * CAP + pos]; }
    }
    __device__ __forceinline__ void epi(const Acc& acc, const Unit& u, int wr, int wc, int fr, int fq, const Pre& q) const {
        const int cnt = u.cnt;
        const int c0 = u.pn * 256 + wc * 64 + 16 * fq;
        f32x4 bd[2][2];
#pragma unroll
        for (int bj = 0; bj < 2; ++bj) { bd[bj][0] = q.bd[bj][0]; bd[bj][1] = q.bd[bj][1]; }
        asm volatile("" :: "v"(bd[0][0]), "v"(bd[0][1]), "v"(bd[1][0]), "v"(bd[1][1]));
        float gwv[2][4]; int dsv[2][4];
#pragma unroll
        for (int ai = 0; ai < 2; ++ai)
#pragma unroll
            for (int m = 0; m < 4; ++m) { gwv[ai][m] = q.gw[ai][m] * 8.0f; dsv[ai][m] = q.ds[ai][m]; }
        asm volatile("" :: "v"(gwv[0][0]), "v"(gwv[0][1]), "v"(gwv[0][2]), "v"(gwv[0][3]), "v"(gwv[1][0]), "v"(gwv[1][1]), "v"(gwv[1][2]), "v"(gwv[1][3]), "v"(dsv[0][0]), "v"(dsv[0][1]), "v"(dsv[0][2]), "v"(dsv[0][3]), "v"(dsv[1][0]), "v"(dsv[1][1]), "v"(dsv[1][2]), "v"(dsv[1][3]), "v"(bd[0][0]), "v"(bd[0][1]), "v"(bd[1][0]), "v"(bd[1][1]));
#pragma unroll
        for (int ai = 0; ai < 2; ++ai)
#pragma unroll
            for (int m = 0; m < 4; ++m) {
                const int pos = u.mt * 256 + ai * 128 + wr * 64 + m * 16 + fr;
                {
                    const float gw = gwv[ai][m]; const int dst = pos < cnt ? dsv[ai][m] : NTOK * 4;
                    u32x2 f8[2];
#pragma unroll
                    for (int bj = 0; bj < 2; ++bj) {
                        const f32x4 v0 = (acc[ai][bj][m][0] * (1.0f / 64.0f) + bd[bj][0]) * gw, v1 = (acc[ai][bj][m][1] * (1.0f / 64.0f) + bd[bj][1]) * gw;
                        f8[bj] = pack8_fp8(v0, v1);
                    }
                    *(u32x4*)(y + (size_t)dst * DM + c0) = (u32x4){f8[0].x, f8[0].y, f8[1].x, f8[1].y};
                }
            }
    }
};
}

struct Params { const float* in[17]; float* out; unsigned char* ws; int ph_lo, ph_hi; };
enum { I_X = 0, I_G1, I_WIN, I_POOLW, I_POOLS, I_FW, I_WOUT, I_G2, I_RW, I_RB, I_WG, I_BG, I_WU, I_BU, I_WD, I_BD, I_GF };

struct Ctx { const Params* p; LAS unsigned char* lds; int tid, lane, wave, G, bid; };

struct TileD { const float* src; bf16_t* dst; const float* rs; const float* cs; int lds_, ldd; float mul; int perm; };
constexpr int NT_WINF = 512, NT_WOUT = 1024, NT_EXP = 4096, NT_SMALL = 64;
constexpr int T0_WOUT = NT_WINF, T0_PW = T0_WOUT, T0_FW = T0_PW + NT_SMALL, NT_BF = T0_FW + NT_SMALL;
constexpr int T8_WU = NT_EXP, T8_WD = 2 * NT_EXP, NT_F8 = 3 * NT_EXP, T8_WOUT_END = NT_F8 + NT_WOUT;
__device__ __forceinline__ TileD tile_desc(const Params& p, int t) {
    TileD d; d.rs = nullptr; d.cs = nullptr; d.mul = 1.f; d.perm = 0;
    unsigned char* ws = p.ws;
    if (t < T0_WOUT) { const int kt = t / 16, n = t % 16;
        d.src = p.in[I_WIN] + (size_t)kt * 128 * 4096 + 2048 + n * 128; d.lds_ = 4096; d.dst = (bf16_t*)(ws + E_WINT) + (size_t)(2048 + n * 128) * 4096 + kt * 128; d.ldd = 4096; d.rs = p.in[I_G1] + kt * 128;
    } else if (t < T0_FW) { const int q = t - T0_PW, g = q / 16, r = q % 16, jt = r / 4, n = r % 4;
        d.src = p.in[I_POOLW] + (size_t)g * 512 * 512 + (size_t)jt * 128 * 512 + n * 128; d.lds_ = 512; d.dst = (bf16_t*)(ws + WS_PWT) + (size_t)g * 512 * 512 + (size_t)(n * 128) * 512 + jt * 128; d.ldd = 512; d.cs = p.in[I_POOLS] + g * 512 + n * 128;
    } else { const int q = t - T0_FW, g = q / 16, r = q % 16, jt = r / 4, n = r % 4;
        d.src = p.in[I_FW] + (size_t)g * 512 * 512 + (size_t)jt * 128 * 512 + n * 128; d.lds_ = 512; d.dst = (bf16_t*)(ws + WS_FWT) + (size_t)g * 512 * 512 + (size_t)(n * 128) * 512 + jt * 128; d.ldd = 512;
    }
    return d;
}
__device__ __forceinline__ TileD tile_desc8(const Params& p, int t) {
    TileD d; d.rs = nullptr; d.cs = nullptr; d.mul = 64.f; d.perm = 0;
    unsigned char* ws = p.ws;
    if (t < T8_WD) { const bool up = t >= T8_WU; const int q = t - (up ? T8_WU : 0), e = q / 128, r = q % 128, kt = r / 4, pn = r % 4;
        d.src = p.in[up ? I_WU : I_WG] + (size_t)e * 4096 * 512 + (size_t)kt * 128 * 512 + pn * 128; d.lds_ = 512;
        d.dst = (bf16_t*)(ws + WS_WGU + ((size_t)e * 1024 + pn * 256 + (up ? 8 : 0)) * 4096 + kt * 128); d.ldd = 4096; d.perm = 1;
    } else if (t < NT_F8) { const int q = t - T8_WD, e = q / 128, r = q % 128, ft = r / 32, dt = r % 32;
        d.src = p.in[I_WD] + (size_t)e * 512 * 4096 + (size_t)ft * 128 * 4096 + dt * 128; d.lds_ = 4096; d.dst = (bf16_t*)(ws + WS_WD + ((size_t)e * 4096 + dt * 128) * 512 + ft * 128); d.ldd = 512;
    } else { const int q = t - NT_F8, kt = q / 32, nn = q % 32;
        d.src = p.in[I_WOUT] + (size_t)kt * 128 * 4096 + nn * 128; d.lds_ = 4096; d.dst = (bf16_t*)(ws + E_WOUTT + (size_t)(nn * 128) * 4096 + kt * 128); d.ldd = 4096;
    }
    return d;
}
constexpr int TP8_PITCH = 144;
__device__ __forceinline__ void tile8_load(const TileD& d, int wave, int lane, f32x4 (&v)[2][4], float (&rs)[2][4]) {
#pragma unroll
    for (int i = 0; i < 2; ++i) { const int bi = wave * 2 + i, rq = (bi >> 2) * 8 + (lane >> 3), cc = (bi & 3) * 8 + (lane & 7);
        const float* s = d.src + (size_t)(4 * rq) * d.lds_ + cc * 4;
#pragma unroll
        for (int r = 0; r < 4; ++r) { v[i][r] = __builtin_nontemporal_load((const f32x4*)(s + (size_t)r * d.lds_)); rs[i][r] = (d.rs ? d.rs[4 * rq + r] : 1.f) * d.mul; } }
}
__device__ __forceinline__ void tile8_to_lds(LAS unsigned char* tl, int wave, int lane, const f32x4 (&v)[2][4], const float (&rs)[2][4]) {
#pragma unroll
    for (int i = 0; i < 2; ++i) { const int bi = wave * 2 + i, rq = (bi >> 2) * 8 + (lane >> 3), cc = (bi & 3) * 8 + (lane & 7);
#pragma unroll
        for (int j = 0; j < 4; ++j) { int w = 0; w = __builtin_amdgcn_cvt_pk_fp8_f32(v[i][0][j] * rs[i][0], v[i][1][j] * rs[i][1], w, false); w = __builtin_amdgcn_cvt_pk_fp8_f32(v[i][2][j] * rs[i][2], v[i][3][j] * rs[i][3], w, true);
            *(LAS int*)(tl + (cc * 4 + j) * TP8_PITCH + rq * 4) = w; } }
}
__device__ __forceinline__ void tile8_store(const TileD& d, const LAS unsigned char* tl, int tid) {
#pragma unroll
    for (int i = 0; i < 2; ++i) { const int q = tid + 512 * i, c = q >> 3, ch = q & 7;
        const u32x4 w = *(const LAS u32x4*)(tl + c * TP8_PITCH + ch * 16);
        const int cr = d.perm ? ((c >> 3) * 16 + (c & 7)) : c;
        __builtin_nontemporal_store(w, (u32x4*)((unsigned char*)d.dst + (size_t)cr * d.ldd + ch * 16)); }
}
constexpr int TP_PITCH = 272;
__device__ __forceinline__ void tile_load(const TileD& d, int wave, int lane, f32x4 (&v)[4][2], float (&rs)[4][2], f32x4 (&cs)[4]) {
#pragma unroll
    for (int i = 0; i < 4; ++i) { const int bi = wave * 4 + i, rp = (bi >> 2) * 8 + (lane >> 3), cc = (bi & 3) * 8 + (lane & 7);
        const float* s = d.src + (size_t)(2 * rp) * d.lds_ + cc * 4;
        v[i][0] = __builtin_nontemporal_load((const f32x4*)s); v[i][1] = __builtin_nontemporal_load((const f32x4*)(s + d.lds_));
        rs[i][0] = d.rs ? d.rs[2 * rp] : 1.f; rs[i][1] = d.rs ? d.rs[2 * rp + 1] : 1.f;
        cs[i] = d.cs ? *(const f32x4*)(d.cs + cc * 4) : (f32x4){1.f, 1.f, 1.f, 1.f}; }
}
__device__ __forceinline__ void tile_to_lds(LAS unsigned char* tl, int wave, int lane, const f32x4 (&v)[4][2], const float (&rs)[4][2], const f32x4 (&cs)[4]) {
#pragma unroll
    for (int i = 0; i < 4; ++i) { const int bi = wave * 4 + i, rp = (bi >> 2) * 8 + (lane >> 3), cc = (bi & 3) * 8 + (lane & 7);
#pragma unroll
        for (int j = 0; j < 4; ++j) *(LAS unsigned*)(tl + (cc * 4 + j) * TP_PITCH + rp * 4) = cvt_pk_bf16(v[i][0][j] * rs[i][0] * cs[i][j], v[i][1][j] * rs[i][1] * cs[i][j]); }
}
__device__ __forceinline__ void tile_store(const TileD& d, const LAS unsigned char* tl, int tid) {
#pragma unroll
    for (int i = 0; i < 4; ++i) { const int q = tid + 512 * i, c = q >> 4, ch = q & 15;
        const u32x4 w = *(const LAS u32x4*)(tl + c * TP_PITCH + ch * 16);
        *(u32x4*)(d.dst + (size_t)c * d.ldd + ch * 8) = w; }
}
__device__ __forceinline__ void convert_tiles8(const Ctx& X, const int tb, const int te, const int k0, const int k1) {
    const Params& p = *X.p;
    f32x4 vA[2][4], vB[2][4]; float rA[2][4], rB[2][4];
    const int step = 2 * X.G;
    int t0 = tb + X.bid + k0 * X.G, t1 = t0 + X.G;
    const long tlim = (long)tb + X.bid + (long)k1 * X.G; const int tend = (int)(tlim < te ? tlim : te);
    TileD dA, dB;
    if (t0 < tend) { dA = tile_desc8(p, t0); tile8_load(dA, X.wave, X.lane, vA, rA); }
    if (t1 < tend) { dB = tile_desc8(p, t1); tile8_load(dB, X.wave, X.lane, vB, rB); }
    LAS unsigned char* tl0 = X.lds; LAS unsigned char* tl1 = X.lds + 128 * TP8_PITCH;
    while (t0 < tend) {
        tile8_to_lds(tl0, X.wave, X.lane, vA, rA);
        const TileD d0 = dA; if (t0 + step < tend) { dA = tile_desc8(p, t0 + step); tile8_load(dA, X.wave, X.lane, vA, rA); }
        __syncthreads();
        tile8_store(d0, tl0, X.tid);
        if (t1 < tend) {
            tile8_to_lds(tl1, X.wave, X.lane, vB, rB);
            const TileD d1 = dB; if (t1 + step < tend) { dB = tile_desc8(p, t1 + step); tile8_load(dB, X.wave, X.lane, vB, rB); }
            __syncthreads();
            tile8_store(d1, tl1, X.tid);
        }
        t0 += step; t1 += step;
    }
    __syncthreads();
}
__device__ __forceinline__ void p0_prep(const Ctx& X) {
    const Params& p = *X.p; unsigned char* ws = p.ws;
    const int gw = X.bid * 8 + X.wave, NGW = X.G * 8, gt = X.bid * NTHREADS + X.tid, NGT = X.G * NTHREADS;
    {   const float* x = p.in[I_X]; bf16_t* xb = (bf16_t*)(ws + E_XB); float* rstd = (float*)(ws + WS_RSTD1);
        for (int r = gw; r < NTOK; r += NGW) {
            const float* xr = x + (size_t)r * DM; f32x4 v[8][2]; float ss = 0.f;
#pragma unroll
            for (int i = 0; i < 8; ++i) { const int c = (i * 64 + X.lane) * 8; v[i][0] = __builtin_nontemporal_load((const f32x4*)(xr + c)); v[i][1] = __builtin_nontemporal_load((const f32x4*)(xr + c + 4)); }
#pragma unroll
            for (int i = 0; i < 8; ++i) {
#pragma unroll
                for (int j = 0; j < 4; ++j) ss += v[i][0][j] * v[i][0][j] + v[i][1][j] * v[i][1][j];
                *(u32x4*)(xb + (size_t)r * DM + (i * 64 + X.lane) * 8) = pack8(v[i][0], v[i][1]); }
            ss = wave_sum(ss);
            if (X.lane == 0) rstd[r] = rsqrtf(ss * (1.0f / DM) + RMS_EPS);
        }
    }
    {   f32x4 vA[4][2], vB[4][2]; float rA[4][2], rB[4][2]; f32x4 cA[4], cB[4];
        int t0 = X.bid, t1 = X.bid + X.G; const int step = 2 * X.G;
        TileD dA, dB;
        if (t0 < NT_BF) { dA = tile_desc(p, t0); tile_load(dA, X.wave, X.lane, vA, rA, cA); }
        if (t1 < NT_BF) { dB = tile_desc(p, t1); tile_load(dB, X.wave, X.lane, vB, rB, cB); }
        LAS unsigned char* tl0 = X.lds; LAS unsigned char* tl1 = X.lds + 128 * TP_PITCH;
        while (t0 < NT_BF) {
            tile_to_lds(tl0, X.wave, X.lane, vA, rA, cA);
            const TileD d0 = dA; if (t0 + step < NT_BF) { dA = tile_desc(p, t0 + step); tile_load(dA, X.wave, X.lane, vA, rA, cA); }
            __syncthreads();
            tile_store(d0, tl0, X.tid);
            if (t1 < NT_BF) {
                tile_to_lds(tl1, X.wave, X.lane, vB, rB, cB);
                const TileD d1 = dB; if (t1 + step < NT_BF) { dB = tile_desc(p, t1 + step); tile_load(dB, X.wave, X.lane, vB, rB, cB); }
                __syncthreads();
                tile_store(d1, tl1, X.tid);
            }
            t0 += step; t1 += step;
        }
        __syncthreads();
    }
    {   const float* w = p.in[I_WIN]; const float* g1 = p.in[I_G1]; bf16_t* o = (bf16_t*)(ws + E_WINP);
        for (int it = gt; it < 4096 * 256; it += NGT) { const int k = it >> 8, j = (it & 255) * 8; const float g = g1[k];
            const f32x4 a = __builtin_nontemporal_load((const f32x4*)(w + (size_t)k * 4096 + j)) * g, b = __builtin_nontemporal_load((const f32x4*)(w + (size_t)k * 4096 + j + 4)) * g;
            *(u32x4*)(o + (size_t)k * 2048 + j) = pack8(a, b); }
    }
    {   bf16_t* o = (bf16_t*)(ws + WS_DFTC);
        for (int it = gt; it < 1024 * 64; it += NGT) { const int n = it >> 6, i0 = (it & 63) * 8; float f[8];
#pragma unroll
            for (int j = 0; j < 8; ++j) { const int m = ((n & 511) * (i0 + j)) & 511; float s, c; sincospif((float)m * (1.0f / 256.0f), &s, &c); f[j] = (n < 512) ? c : s; }
            u32x4 w; w.x = cvt_pk_bf16(f[0], f[1]); w.y = cvt_pk_bf16(f[2], f[3]); w.z = cvt_pk_bf16(f[4], f[5]); w.w = cvt_pk_bf16(f[6], f[7]);
            *(u32x4*)(o + (size_t)n * 512 + i0) = w; }
    }
    {   const float* rw = p.in[I_RW]; const float* g2 = p.in[I_G2]; bf16_t* o = (bf16_t*)(ws + WS_RWT);
        for (int it = gt; it < 32 * 4096; it += NGT) { const int e = it >> 12, k = it & 4095; const float v = g2[k] * rw[k * 32 + e];
            const unsigned hi = cvt_pk_bf16(v, 0.f) & 0xffffu; const float lo = v - __uint_as_float(hi << 16);
            o[(size_t)e * 4096 + k] = (bf16_t)hi; o[(size_t)(32 + e) * 4096 + k] = (bf16_t)(cvt_pk_bf16(lo, 0.f) & 0xffffu); }
    }
}

__device__ __forceinline__ void p3_mix_prep(const Ctx& X) {
    const Params& p = *X.p; unsigned char* ws = p.ws;
    const bf16_t* u = (const bf16_t*)(ws + E_U); unsigned char* mixed = ws + E_MIXED;
    const int gt = X.bid * NTHREADS + X.tid, NGT = X.G * NTHREADS;
    constexpr int PP = 528;
    {   u32x4 ld[5];
        bf16_t* vv = (bf16_t*)(ws + E_VEVO);
        auto issue = [&](int w) { const int b = w >> 9, rem = w & 511, tt = rem >> 3, gc = rem & 7, g = gc >> 1, ch0 = g * 512 + (gc & 1) * 256, t0 = tt * 64;
#pragma unroll
            for (int i = 0; i < 5; ++i) { const int q = X.tid + 512 * i, rr = q >> 5, cq = q & 31, t = min(max(t0 - 8 + rr, 0), SEQ - 1);
                ld[i] = __builtin_nontemporal_load((const u32x4*)(u + (size_t)(b * SEQ + t) * DM + ch0 + cq * 8)); } };
        int w = X.bid; int it0 = gt;
        if (w < 2048) issue(w);
        while (w < 2048 || it0 < (NTOK / 2) * 256) {
            const bool dov = it0 < (NTOK / 2) * 256, dop = w < 2048;
            u32x4 va[4], vr[4];
            if (dov) {
#pragma unroll
                for (int k = 0; k < 4; ++k) { const int it = it0 + k * NGT, tokp = it >> 8, q = it & 255, b = tokp >> 11, sq = tokp & 2047, rs = (SEQ - sq) & (SEQ - 1);
                    va[k] = *(const u32x4*)(u + (size_t)(b * SEQ + sq) * DM + 2048 + q * 8); vr[k] = *(const u32x4*)(u + (size_t)(b * SEQ + rs) * DM + 2048 + q * 8); } }
            if (dop) {
                const int b = w >> 9, rem = w & 511, tt = rem >> 3, gc = rem & 7, g = gc >> 1, ch0 = g * 512 + (gc & 1) * 256;
                const int t0 = tt * 64, hw = 1 << g;
#pragma unroll
                for (int i = 0; i < 5; ++i) { const int q = X.tid + 512 * i, rr = q >> 5, cq = q & 31; if (rr < 79) *(LAS u32x4*)(X.lds + rr * PP + cq * 16) = ld[i]; }
                __syncthreads();
                if (w + X.G < 2048) issue(w + X.G);
                {
                    const int cq = X.tid & 31, tl0 = (X.tid >> 5) * 4;
                    float sm[8] = {0.f, 0.f, 0.f, 0.f, 0.f, 0.f, 0.f, 0.f};
                    {   const int t = t0 + tl0, lo = max(t - hw, 0), hi = min(t + hw - 1, SEQ - 1);
                        for (int r = lo; r <= hi; ++r) { const u32x4 v = *(const LAS u32x4*)(X.lds + (r - t0 + 8) * PP + cq * 16);
                            sm[0] += bf_lo(v.x); sm[1] += bf_hi(v.x); sm[2] += bf_lo(v.y); sm[3] += bf_hi(v.y); sm[4] += bf_lo(v.z); sm[5] += bf_hi(v.z); sm[6] += bf_lo(v.w); sm[7] += bf_hi(v.w); } }
#pragma unroll
                    for (int j = 0; j < 4; ++j) { const int tl = tl0 + j, t = t0 + tl;
                        if (j > 0) {
                            const int re = t - 1 + hw, rl = t - 1 - hw;
                            if (re <= SEQ - 1) { const u32x4 v = *(const LAS u32x4*)(X.lds + (re - t0 + 8) * PP + cq * 16);
                                sm[0] += bf_lo(v.x); sm[1] += bf_hi(v.x); sm[2] += bf_lo(v.y); sm[3] += bf_hi(v.y); sm[4] += bf_lo(v.z); sm[5] += bf_hi(v.z); sm[6] += bf_lo(v.w); sm[7] += bf_hi(v.w); }
                            if (rl >= 0) { const u32x4 v = *(const LAS u32x4*)(X.lds + (rl - t0 + 8) * PP + cq * 16);
                                sm[0] -= bf_lo(v.x); sm[1] -= bf_hi(v.x); sm[2] -= bf_lo(v.y); sm[3] -= bf_hi(v.y); sm[4] -= bf_lo(v.z); sm[5] -= bf_hi(v.z); sm[6] -= bf_lo(v.w); sm[7] -= bf_hi(v.w); } }
                        const int lo = max(t - hw, 0), hi = min(t + hw - 1, SEQ - 1);
                        const u32x4 cv = *(const LAS u32x4*)(X.lds + (tl + 8) * PP + cq * 16);
                        const float inv = 1.0f / (float)(hi - lo + 1);
                        const f32x4 o0 = {sm[0] * inv - bf_lo(cv.x), sm[1] * inv - bf_hi(cv.x), sm[2] * inv - bf_lo(cv.y), sm[3] * inv - bf_hi(cv.y)};
                        const f32x4 o1 = {sm[4] * inv - bf_lo(cv.z), sm[5] * inv - bf_hi(cv.z), sm[6] * inv - bf_lo(cv.w), sm[7] * inv - bf_hi(cv.w)};
                        *(u32x2*)(mixed + (size_t)(b * SEQ + t) * DM + ch0 + cq * 8) = g8::pack8_fp8(o0, o1); }
                }
            }
            if (dov) {
#pragma unroll
                for (int k = 0; k < 4; ++k) { const int it = it0 + k * NGT, tok = it >> 8, q = it & 255;
                    const u32x4 a = va[k], r = vr[k]; u32x4 e, o;
                    e.x = cvt_pk_bf16(0.5f * (bf_lo(a.x) + bf_lo(r.x)), 0.5f * (bf_hi(a.x) + bf_hi(r.x))); o.x = cvt_pk_bf16(0.5f * (bf_lo(a.x) - bf_lo(r.x)), 0.5f * (bf_hi(a.x) - bf_hi(r.x)));
                    e.y = cvt_pk_bf16(0.5f * (bf_lo(a.y) + bf_lo(r.y)), 0.5f * (bf_hi(a.y) + bf_hi(r.y))); o.y = cvt_pk_bf16(0.5f * (bf_lo(a.y) - bf_lo(r.y)), 0.5f * (bf_hi(a.y) - bf_hi(r.y)));
                    e.z = cvt_pk_bf16(0.5f * (bf_lo(a.z) + bf_lo(r.z)), 0.5f * (bf_hi(a.z) + bf_hi(r.z))); o.z = cvt_pk_bf16(0.5f * (bf_lo(a.z) - bf_lo(r.z)), 0.5f * (bf_hi(a.z) - bf_hi(r.z)));
                    e.w = cvt_pk_bf16(0.5f * (bf_lo(a.w) + bf_lo(r.w)), 0.5f * (bf_hi(a.w) + bf_hi(r.w))); o.w = cvt_pk_bf16(0.5f * (bf_lo(a.w) - bf_lo(r.w)), 0.5f * (bf_hi(a.w) - bf_hi(r.w)));
                    const int h = q >> 6, j = (q & 63) * 8;
                    *(u32x4*)(vv + (size_t)tok * DM + h * 1024 + j) = e; *(u32x4*)(vv + (size_t)tok * DM + h * 1024 + 512 + j) = o; }
            }
            if (dop) __syncthreads();
            w += X.G; it0 += 4 * NGT;
        }
    }
}

typedef short s16x4 __attribute__((ext_vector_type(4)));
constexpr int FT_PITCH = 544;
__device__ __forceinline__ bf16x8 fft_afrag(const LAS unsigned char* tile, int lane, int ks, int cb  ) {
    const int g = lane >> 4, q = (lane & 15) >> 2, pp = lane & 3;
    const LAS unsigned char* a0 = tile + (32 * ks + 8 * g + q) * FT_PITCH + (cb + 4 * pp) * 2;
    const s16x4 lo = __builtin_amdgcn_ds_read_tr16_b64_v4i16((LAS s16x4*)a0), hi = __builtin_amdgcn_ds_read_tr16_b64_v4i16((LAS s16x4*)(a0 + 4 * FT_PITCH));
    return __builtin_shufflevector(lo, hi, 0, 1, 2, 3, 4, 5, 6, 7);
}
__device__ __forceinline__ bf16x8 pack_frag(const float (&f)[8]) {
    u32x4 w; w.x = cvt_pk_bf16(f[0], f[1]); w.y = cvt_pk_bf16(f[2], f[3]); w.z = cvt_pk_bf16(f[4], f[5]); w.w = cvt_pk_bf16(f[6], f[7]); return __builtin_bit_cast(bf16x8, w);
}
__device__ __forceinline__ void p5a_fft1(const Ctx& X) {
    const Params& p = *X.p; unsigned char* ws = p.ws;
    const bf16_t* Q = (const bf16_t*)(ws + E_QT); bf16_t* T = (bf16_t*)(ws + E_T);
    LAS unsigned char* tile = X.lds; LAS float* cs = (LAS float*)(X.lds + 98304);
    if (X.tid < 64) { float sn, c; sincospif((float)X.tid * (1.0f / 32.0f), &sn, &c); cs[X.tid] = c; cs[64 + X.tid] = sn; }
    __syncthreads();
    const int fr = X.lane & 15, fq = X.lane >> 4, cbw = X.wave * 32;
    bf16x8 bfr[8][2];
#pragma unroll
    for (int ni = 0; ni < 8; ++ni)
#pragma unroll
        for (int ks = 0; ks < 2; ++ks) { float f[8];
#pragma unroll
            for (int j = 0; j < 8; ++j) { const int k1 = (16 * ni + fr) & 63, n1 = 32 * ks + 8 * fq + j, m = (k1 * n1) & 63; f[j] = (ni < 4) ? cs[m] : -cs[64 + m]; }
            bfr[ni][ks] = pack_frag(f); }
    u32x4 ld[4], lo[4];
    const bf16_t* Q2048 = (const bf16_t*)(ws + WS_PWT);
    int it = X.bid;
    auto issue = [&](int item) { const int b = item >> 9, n2 = (item >> 3) & 63, ch = item & 7;
#pragma unroll
        for (int i = 0; i < 4; ++i) { const int q = X.tid + 512 * i, n1 = q >> 5, pc = q & 31, sq = 64 * n1 + n2, sp = sq <= 2048 ? sq : SEQ - sq, col = ch * 256 + pc * 8;
            const bf16_t* pe = (sq == 2048) ? Q2048 + b * 2048 + col : Q + (size_t)(b * 2048 + sp) * 4096 + (col >> 9) * 1024 + (col & 511);
            ld[i] = __builtin_nontemporal_load((const u32x4*)pe); lo[i] = __builtin_nontemporal_load((const u32x4*)(sq == 2048 ? pe : pe + 512)); } };
    auto comb = [&](int i, int n2) -> u32x4 { const int q = X.tid + 512 * i, sq = 64 * (q >> 5) + n2; const float sg = sq < 2048 ? 1.0f : (sq == 2048 ? 0.0f : -1.0f);
        const u32x4 e = ld[i], o = lo[i]; u32x4 r;
        r.x = cvt_pk_bf16(bf_lo(e.x) + sg * bf_lo(o.x), bf_hi(e.x) + sg * bf_hi(o.x)); r.y = cvt_pk_bf16(bf_lo(e.y) + sg * bf_lo(o.y), bf_hi(e.y) + sg * bf_hi(o.y));
        r.z = cvt_pk_bf16(bf_lo(e.z) + sg * bf_lo(o.z), bf_hi(e.z) + sg * bf_hi(o.z)); r.w = cvt_pk_bf16(bf_lo(e.w) + sg * bf_lo(o.w), bf_hi(e.w) + sg * bf_hi(o.w)); return r; };
    if (it < 2048) issue(it);
    for (; it < 2048; it += X.G) {
        const int b = it >> 9, n2 = (it >> 3) & 63, ch = it & 7;
#pragma unroll
        for (int i = 0; i < 4; ++i) { const int q = X.tid + 512 * i; *(LAS u32x4*)(tile + (q >> 5) * FT_PITCH + (q & 31) * 16) = comb(i, n2); }
        __syncthreads();
        if (it + X.G < 2048) issue(it + X.G);
        f32x4 acc[2][8]; f32x4 zz = {0.f, 0.f, 0.f, 0.f}; asm volatile("" : "+v"(zz));
#pragma unroll
        for (int mf = 0; mf < 2; ++mf)
#pragma unroll
            for (int ni = 0; ni < 8; ++ni) acc[mf][ni] = zz;
#pragma unroll
        for (int mf = 0; mf < 2; ++mf)
#pragma unroll
            for (int ks = 0; ks < 2; ++ks) { const bf16x8 af = fft_afrag(tile, X.lane, ks, cbw + 16 * mf);
#pragma unroll
                for (int ni = 0; ni < 8; ++ni) asm volatile("v_mfma_f32_16x16x32_bf16 %0, %1, %2, %0" : "+v"(acc[mf][ni]) : "v"(af), "v"(bfr[ni][ks])); }
        asm volatile("s_nop 15\n\ts_nop 15" ::: "memory");
#pragma unroll
        for (int ni = 0; ni < 4; ++ni) { const int k1 = 16 * ni + fr; const float rev = (float)(n2 * k1) * (1.0f / 4096.0f); const float sn = __builtin_amdgcn_sinf(rev), c = __builtin_amdgcn_cosf(rev);
            bf16_t* tr = T + ((size_t)((b * 64 + k1) * 64 + n2) * 2) * 2048 + ch * 256 + cbw + 4 * fq;
#pragma unroll
            for (int mf = 0; mf < 2; ++mf) { const f32x4 re = acc[mf][ni], im = acc[mf][ni + 4];
                const f32x4 t_r = re * c + im * sn, t_i = im * c - re * sn;
                u32x2 w; w.x = cvt_pk_bf16(t_r[0], t_r[1]); w.y = cvt_pk_bf16(t_r[2], t_r[3]); *(u32x2*)(tr + 16 * mf) = w;
                w.x = cvt_pk_bf16(t_i[0], t_i[1]); w.y = cvt_pk_bf16(t_i[2], t_i[3]); *(u32x2*)(tr + 2048 + 16 * mf) = w; } }
        __syncthreads();
    }
}
__device__ __forceinline__ void p5b_fft2(const Ctx& X) {
    const Params& p = *X.p; unsigned char* ws = p.ws;
    const bf16_t* T = (const bf16_t*)(ws + E_T); unsigned char* mixed = ws + E_MIXED;
    LAS unsigned char* tile = X.lds; LAS float* cs = (LAS float*)(X.lds + 98304);
    if (X.tid < 64) { float sn, c; sincospif((float)X.tid * (1.0f / 32.0f), &sn, &c); cs[X.tid] = c; cs[64 + X.tid] = sn; }
    __syncthreads();
    const int fr = X.lane & 15, fq = X.lane >> 4, cbw = X.wave * 32;
    const float sc = 1.0f / sqrtf((float)SEQ * 512.0f);
    bf16x8 bfr[4][4];
#pragma unroll
    for (int ni = 0; ni < 4; ++ni)
#pragma unroll
        for (int ks = 0; ks < 4; ++ks) { float f[8];
#pragma unroll
            for (int j = 0; j < 8; ++j) { const int k2 = 16 * ni + fr, kk = 32 * ks + 8 * fq + j, n2 = kk >> 1, m = (k2 * n2) & 63; const float c = cs[m], sn = cs[64 + m]; f[j] = ((kk & 1) ? (c + sn) : (c - sn)) * sc; }
            bfr[ni][ks] = pack_frag(f); }
    u32x4 ld[8];
    int it = X.bid;
    auto issue = [&](int item) { const int b = item >> 9, k1 = (item >> 3) & 63, ch = item & 7;
#pragma unroll
        for (int i = 0; i < 8; ++i) { const int q = X.tid + 512 * i, kk = q >> 5, pc = q & 31; ld[i] = __builtin_nontemporal_load((const u32x4*)(T + ((size_t)(b * 64 + k1) * 128 + kk) * 2048 + ch * 256 + pc * 8)); } };
    if (it < 2048) issue(it);
    for (; it < 2048; it += X.G) {
        const int b = it >> 9, k1 = (it >> 3) & 63, ch = it & 7;
#pragma unroll
        for (int i = 0; i < 8; ++i) { const int q = X.tid + 512 * i; *(LAS u32x4*)(tile + (q >> 5) * FT_PITCH + (q & 31) * 16) = ld[i]; }
        __syncthreads();
        if (it + X.G < 2048) issue(it + X.G);
        f32x4 acc[2][4]; f32x4 zz = {0.f, 0.f, 0.f, 0.f}; asm volatile("" : "+v"(zz));
#pragma unroll
        for (int mf = 0; mf < 2; ++mf)
#pragma unroll
            for (int ni = 0; ni < 4; ++ni) acc[mf][ni] = zz;
#pragma unroll
        for (int mf = 0; mf < 2; ++mf)
#pragma unroll
            for (int ks = 0; ks < 4; ++ks) { const bf16x8 af = fft_afrag(tile, X.lane, ks, cbw + 16 * mf);
#pragma unroll
                for (int ni = 0; ni < 4; ++ni) asm volatile("v_mfma_f32_16x16x32_bf16 %0, %1, %2, %0" : "+v"(acc[mf][ni]) : "v"(af), "v"(bfr[ni][ks])); }
        asm volatile("s_nop 15\n\ts_nop 15" ::: "memory");
#pragma unroll
        for (int ni = 0; ni < 4; ++ni) { const int k2 = 16 * ni + fr;
            unsigned char* o = mixed + (size_t)(b * SEQ + k1 + 64 * k2) * DM + 2048 + ch * 256 + cbw + 4 * fq;
#pragma unroll
            for (int mf = 0; mf < 2; ++mf) { const f32x4 v = acc[mf][ni]; int w = 0; w = __builtin_amdgcn_cvt_pk_fp8_f32(v[0], v[1], w, false); w = __builtin_amdgcn_cvt_pk_fp8_f32(v[2], v[3], w, true); *(int*)(o + 16 * mf) = w; } }
        __syncthreads();
    }
}

__device__ __forceinline__ void p7_router(const Ctx& X, const size_t tb  , const size_t cb) {
    const Params& p = *X.p; unsigned char* ws = p.ws;
    const bf16_t* h1 = (const bf16_t*)(ws + WS_H1B); const bf16_t* rwt = (const bf16_t*)(ws + WS_RWT);
    int* rowtok = (int*)(ws + WS_ROWTOK + tb); float* rowrstd = (float*)(ws + WS_ROWRSTD + tb); float* rowgate = (float*)(ws + WS_ROWGATE + tb); int* rowdst = (int*)(ws + WS_ROWDST + tb);
    unsigned* gcnt = (unsigned*)(ws + WS_CTL + CTL_CNT + cb);
    LAS float* part = (LAS float*)X.lds;
    LAS float* ssq = (LAS float*)(X.lds + LX_RT);
    LAS float* lg = (LAS float*)(X.lds + LX_RT + 2048);
    LAS int* lcnt = (LAS int*)(X.lds + LX_RT + 2048 + 8192);
    LAS int* gb = lcnt + 32;
    LAS float* rstl = (LAS float*)(X.lds + LX_RT + 2048 + 8192 + 256);
    LAS float* gvs = (LAS float*)(X.lds + LX_RT + 2048 + 8192 + 512);
    for (int tt = X.bid; tt < NTOK / 64; tt += X.G) {
        int lzq = g8::lane_id_v();
        const int fr = lzq & 15, fq = lzq >> 4;
        const int tok0 = tt * 64;
        f32x4 acc[4][4]; float ss[4] = {0.f, 0.f, 0.f, 0.f};
#pragma unroll
        for (int a = 0; a < 4; ++a)
#pragma unroll
            for (int b = 0; b < 4; ++b) acc[a][b] = (f32x4){0.f, 0.f, 0.f, 0.f};
        {
        LAS unsigned char* wreg = X.lds + X.wave * 16384;
        const int l16 = lzq & 15, l4 = lzq >> 4;
        bf16x8 ld[16], bfb[4][4];
        const __amdgpu_buffer_rsrc_t rsH = __builtin_amdgcn_make_buffer_rsrc((void*)(h1 + (size_t)tok0 * DM), (short)0, (int)(64 * DM * 2), 0x00020000);
        const __amdgpu_buffer_rsrc_t rsR = __builtin_amdgcn_make_buffer_rsrc((void*)rwt, (short)0, (int)(64 * DM * 2), 0x00020000);
        const int vH = l4 * (DM * 2) + X.wave * 1024 + l16 * 16, vR = fr * (DM * 2) + X.wave * 1024 + fq * 16;
#define P7_GLOAD(q) do { _Pragma("unroll") for (int j = 0; j < 16; ++j) ld[j] = __builtin_bit_cast(bf16x8, __builtin_amdgcn_raw_buffer_load_b128(rsH, vH, j * (4 * DM * 2) + (q) * 256, 2)); } while (0)
        LAS unsigned char* wb[4]; LAS const unsigned char* rb[4];
#pragma unroll
        for (int jj = 0; jj < 4; ++jj) { const int row = 4 * jj + l4; wb[jj] = wreg + row * 256 + ((l16 ^ (row & 15)) * 16); rb[jj] = wreg + fr * 256 + (((jj * 4 + fq) ^ fr) * 16); }
#define P7_LWRITE() do { _Pragma("unroll") for (int j = 0; j < 16; ++j) *(LAS bf16x8*)(wb[j & 3] + (j >> 2) * 4096) = ld[j]; } while (0)
#define P7_BLOAD(st, kk) do { _Pragma("unroll") for (int ni = 0; ni < 4; ++ni) bfb[st][ni] = __builtin_bit_cast(bf16x8, __builtin_amdgcn_raw_buffer_load_b128(rsR, vR, ni * (16 * DM * 2) + (kk) * 64, 0)); } while (0)
        P7_GLOAD(0);
#pragma unroll 1
        for (int q = 0; q < 4; ++q) {
            P7_LWRITE();
            __builtin_amdgcn_sched_barrier(0);
            P7_BLOAD(0, q * 4); P7_BLOAD(1, q * 4 + 1); P7_BLOAD(2, q * 4 + 2); P7_BLOAD(3, q * 4 + 3);
            __builtin_amdgcn_sched_barrier(0);
            { const int qn = q < 3 ? q + 1 : 3; P7_GLOAD(qn); }
            __builtin_amdgcn_sched_barrier(0);
#pragma unroll
            for (int ks = 0; ks < 4; ++ks) {
                __builtin_amdgcn_sched_barrier(0);
#pragma unroll
                for (int mi = 0; mi < 4; ++mi) {
                    const bf16x8 af = *(const LAS bf16x8*)(rb[ks] + mi * 4096);
#pragma unroll
                    for (int j = 0; j < 8; ++j) { const float f = __uint_as_float(((unsigned)(unsigned short)af[j]) << 16); ss[mi] += f * f; }
#pragma unroll
                    for (int ni = 0; ni < 4; ++ni) asm volatile("v_mfma_f32_16x16x32_bf16 %0, %1, %2, %0" : "+v"(acc[mi][ni]) : "v"(af), "v"(bfb[ks & 3][ni]));
                }
                __builtin_amdgcn_sched_barrier(0);
            }
        }
        asm volatile("s_nop 15\n\ts_nop 15" ::: "memory");
        __builtin_amdgcn_s_waitcnt(0);
#undef P7_GLOAD
#undef P7_LWRITE
#undef P7_BLOAD
        }
        const int tq = X.wave * 64 + g8::lane_id_v();
#pragma unroll
        for (int mi = 0; mi < 4; ++mi) {
#pragma unroll
            for (int ni = 0; ni < 4; ++ni)
#pragma unroll
                for (int r = 0; r < 4; ++r) part[(X.wave * 64 + mi * 16 + 4 * fq + r) * 64 + ni * 16 + fr] = acc[mi][ni][r];
            float s = ss[mi]; s += __shfl_xor(s, 16); s += __shfl_xor(s, 32);
            if (fq == 0) ssq[X.wave * 64 + mi * 16 + fr] = s;
        }
        if (tq < 32) lcnt[tq] = 0;
        __syncthreads();
        {   const int tk = tq >> 3, eg = tq & 7;
            float sq = 0.f;
#pragma unroll
            for (int w = 0; w < 8; ++w) sq += ssq[w * 64 + tk];
            const float rstd = rsqrtf(sq * (1.0f / DM) + RMS_EPS);
#pragma unroll
            for (int j = 0; j < 4; ++j) { const int e = eg * 4 + j; float a = 0.f;
#pragma unroll
                for (int w = 0; w < 8; ++w) a += part[(w * 64 + tk) * 64 + e] + part[(w * 64 + tk) * 64 + 32 + e];
                lg[tk * 32 + e] = a * rstd + p.in[I_RB][e]; }
            if (eg == 0) rstl[tk] = rstd;
        }
        __syncthreads();
        int ei[4]; float gv[4]; int lp[4]; float rstd_t = 0.f;
        if (tq < 64) {
            const int tk = tq; rstd_t = rstl[tk];
            float tv[4];
#pragma unroll
            for (int k = 0; k < 4; ++k) { float best = -3.0e38f; int bi = 0;
                for (int e = 0; e < 32; ++e) { const float v = lg[tk * 32 + e]; if (v > best) { best = v; bi = e; } }
                tv[k] = best; ei[k] = bi; lg[tk * 32 + bi] = -3.0e38f; }
            float den = 0.f;
#pragma unroll
            for (int k = 0; k < 4; ++k) { gv[k] = __expf(tv[k] - tv[0]); den += gv[k]; }
            const float inv = 1.0f / den;
#pragma unroll
            for (int k = 0; k < 4; ++k) { gvs[tk * 4 + k] = gv[k] * inv; lp[k] = atomicAdd((int*)&lcnt[ei[k]], 1); }
        }
        __syncthreads();
        if (tq < 32) { const int n = lcnt[tq]; gb[tq] = n ? (int)atomicAdd(&gcnt[tq], (unsigned)n) : 0; }
        __syncthreads();
        if (tq < 64) {
            const int tok = tok0 + tq;
#pragma unroll
            for (int k = 0; k < 4; ++k) { const int idx = ei[k] * CAP + gb[ei[k]] + lp[k];
                rowtok[idx] = tok; rowrstd[idx] = rstd_t; rowgate[idx] = gvs[tq * 4 + k]; rowdst[idx] = tok * 4 + k; }
        }
        __syncthreads();
    }
}

__device__ __forceinline__ int moe_tables(const Ctx& X) {
    const unsigned* gcnt = (const unsigned*)(X.p->ws + WS_CTL + CTL_CNT);
    int* tab = (int*)(X.p->ws + WS_TABG) + (size_t)X.bid * 2048;
    if (X.tid < 64) {
        const int e = X.lane & 31;
        const int c = (int)__hip_atomic_load(gcnt + e, __ATOMIC_RELAXED, __HIP_MEMORY_SCOPE_AGENT), nt = (c + 255) >> 8;
        int rb = c, ts = nt;
#pragma unroll
        for (int o = 1; o < 32; o <<= 1) { const int r2 = __shfl_up(rb, o), t2 = __shfl_up(ts, o); if (e >= o) { rb += r2; ts += t2; } }
        if (X.lane < 32) { const int rb0 = rb - c, ts0 = ts - nt;
            for (int j = 0; j < nt; ++j) { int* r = tab + 4 + 4 * (ts0 + j); r[0] = e; r[1] = j; r[2] = c; r[3] = rb0; }
            if (e == 31) tab[0] = ts; }
    }
    asm volatile("s_waitcnt vmcnt(0)" ::: "memory");
    __syncthreads();
    return __builtin_amdgcn_readfirstlane(__hip_atomic_load(tab, __ATOMIC_RELAXED, __HIP_MEMORY_SCOPE_AGENT));
}

__device__ __forceinline__ void p10_combine(const Ctx& X) {
    const Params& p = *X.p; unsigned char* ws = p.ws;
    const bf16_t* h1 = (const bf16_t*)(ws + WS_H1B); const unsigned char* y = ws + E_Y; const float* gf = p.in[I_GF]; float* out = p.out;
    const int gw = X.bid * 8 + X.wave, NGW = X.G * 8;
    for (int tok = gw; tok < NTOK; tok += NGW) {
        float v[8][8]; float ss = 0.f;
#pragma unroll
        for (int ib = 0; ib < 8; ib += 4) {
            u32x4 a[4]; u32x2 yk[4][4];
#pragma unroll
            for (int ii = 0; ii < 4; ++ii) { const int c = ((ib + ii) * 64 + X.lane) * 8;
                a[ii] = __builtin_nontemporal_load((const u32x4*)(h1 + (size_t)tok * DM + c));
#pragma unroll
                for (int k = 0; k < 4; ++k) yk[ii][k] = __builtin_nontemporal_load((const u32x2*)(y + ((size_t)tok * 4 + k) * DM + c)); }
#pragma unroll
            for (int ii = 0; ii < 4; ++ii) { const int i = ib + ii; const u32x4 w = a[ii];
                float s8[8] = {0.f, 0.f, 0.f, 0.f, 0.f, 0.f, 0.f, 0.f};
#pragma unroll
                for (int k = 0; k < 4; ++k) {
                    const f32x2 p0 = __builtin_amdgcn_cvt_pk_f32_fp8((int)yk[ii][k].x, false), p1 = __builtin_amdgcn_cvt_pk_f32_fp8((int)yk[ii][k].x, true);
                    const f32x2 p2 = __builtin_amdgcn_cvt_pk_f32_fp8((int)yk[ii][k].y, false), p3 = __builtin_amdgcn_cvt_pk_f32_fp8((int)yk[ii][k].y, true);
                    s8[0] += p0.x; s8[1] += p0.y; s8[2] += p1.x; s8[3] += p1.y; s8[4] += p2.x; s8[5] += p2.y; s8[6] += p3.x; s8[7] += p3.y; }
                v[i][0] = bf_lo(w.x) + 0.125f * s8[0]; v[i][1] = bf_hi(w.x) + 0.125f * s8[1]; v[i][2] = bf_lo(w.y) + 0.125f * s8[2]; v[i][3] = bf_hi(w.y) + 0.125f * s8[3];
                v[i][4] = bf_lo(w.z) + 0.125f * s8[4]; v[i][5] = bf_hi(w.z) + 0.125f * s8[5]; v[i][6] = bf_lo(w.w) + 0.125f * s8[6]; v[i][7] = bf_hi(w.w) + 0.125f * s8[7];
#pragma unroll
                for (int j = 0; j < 8; ++j) ss += v[i][j] * v[i][j]; }
            asm volatile("" ::: "memory");
        }
        ss = wave_sum(ss);
        const float rstd = rsqrtf(ss * (1.0f / DM) + RMS_EPS);
#pragma unroll
        for (int i = 0; i < 8; ++i) { const int c = (i * 64 + X.lane) * 8;
            const f32x4 g0 = *(const f32x4*)(gf + c), g1 = *(const f32x4*)(gf + c + 4);
            f32x4 o0, o1;
#pragma unroll
            for (int j = 0; j < 4; ++j) { o0[j] = v[i][j] * rstd * g0[j]; o1[j] = v[i][4 + j] * rstd * g1[j]; }
            __builtin_nontemporal_store(o0, (f32x4*)(out + (size_t)tok * DM + c)); __builtin_nontemporal_store(o1, (f32x4*)(out + (size_t)tok * DM + c + 4)); }
    }
}

__global__ void __launch_bounds__(NTHREADS, 2) mk_fwd(Params prm) {
    extern __shared__ __attribute__((aligned(16))) unsigned char lds_raw[];
    Ctx X; X.p = &prm; X.lds = (LAS unsigned char*)lds_raw; X.tid = threadIdx.x; X.lane = X.tid & 63; X.wave = __builtin_amdgcn_readfirstlane(X.tid >> 6); X.G = gridDim.x; X.bid = blockIdx.x;
#define RECTX() do { int _lz = (int)__builtin_amdgcn_mbcnt_hi(~0u, __builtin_amdgcn_mbcnt_lo(~0u, 0u)); asm volatile("" : "+v"(_lz)); X.lane = _lz; X.tid = X.wave * 64 + _lz; } while (0)
    unsigned char* ws = prm.ws;
    const int lo = prm.ph_lo, hi = prm.ph_hi;
#if !MK_PER_PHASE
    if (X.tid == 0) *(LAS u32x4*)(X.lds + LX_BAR) = (u32x4){0u, 0u, 0u, 0u};
    __syncthreads();
    XcdBarrier bar = xcd_barrier_post((unsigned*)(ws + WS_CTL), (volatile LAS unsigned*)(X.lds + LX_BAR));
#define GRID_BAR() xcd_barrier(bar, X.wave == 0 && g8::lane_id_v() == 0)
#else
#define GRID_BAR() do {} while (0)
#endif
#ifdef MK_ONLY
#define IN(k) ((k) == MK_ONLY)
#else
#define IN(k) (lo <= (k) && (k) < hi)
#endif
#define SEAM(k) do { if (IN((k) + 1)) GRID_BAR(); } while (0)
    LAS unsigned char* stage = X.lds;

    if (IN(0)) { RECTX(); p0_prep(X); if (MK_DOUBLE == 0) { __syncthreads(); p0_prep(X); } SEAM(0); }

    if (IN(1)) {
        {   g8::DenseP<0> P{}; P.A = (const char*)(ws + WS_PWT); P.B = (const char*)(ws + E_WINP); P.C = (bf16_t*)(ws + E_WINT);
            P.lda2 = 1024; P.ldb2 = 4096; P.nt = 8; P.nM = 8; P.nN = 16; P.G = X.G; P.c = X.bid; P.mPer = 2; P.bDiv = 1; P.ldc = 4096;
            P.aHi = 512 * 512 * 2; P.aLo = 0; P.bHi = 512 * 2; P.bLo = 0; P.cHi = (size_t)512 * 4096; P.cLo = 0; P.rowscale = nullptr; P.resid = nullptr;
            g8::gemm_phase(stage, P, X.wave); }
        {   g8::DenseP<0> P{}; P.A = (const char*)(ws + WS_FWT); P.B = (const char*)(ws + WS_DFTC); P.C = (bf16_t*)(ws + WS_GT);
            P.lda2 = 1024; P.ldb2 = 1024; P.nt = 8; P.nM = 8; P.nN = 4; P.G = X.G; P.c = (X.bid + 128) % X.G; P.mPer = 2; P.bDiv = 1; P.ldc = 1024;
            P.aHi = 512 * 512 * 2; P.aLo = 0; P.bHi = 0; P.bLo = 0; P.cHi = (size_t)512 * 1024; P.cLo = 0; P.rowscale = nullptr; P.resid = nullptr;
            g8::gemm_phase(stage, P, X.wave); }
        SEAM(1);
    }

    if (IN(2)) { RECTX();
        g8::DenseP<1, false, 1> P{}; P.A = (const char*)(ws + E_XB); P.B = (const char*)(ws + E_WINT); P.C = (bf16_t*)(ws + E_U);
        P.lda2 = 8192; P.ldb2 = 8192; P.nt = 64; P.nM = 64; P.nN = 16; P.G = X.G; P.c = X.bid; P.mPer = 64; P.bDiv = 1; P.ldc = 4096;
        P.aHi = 0; P.aLo = 0; P.bHi = 0; P.bLo = 0; P.cHi = 0; P.cLo = 0; P.rowscale = (const float*)(ws + WS_RSTD1); P.resid = nullptr;
        const int nun = X.bid < 64 * 16 ? (64 * 16 - X.bid + X.G - 1) / X.G : 0, per = X.bid < T8_WD ? (T8_WD - X.bid + X.G - 1) / X.G : 0, inl = min(per, nun * 64 / 8);
        P.ssrc0 = prm.in[I_WG]; P.ssrc1 = prm.in[I_WU]; P.sdst = ws + WS_WGU; P.sbid = X.bid; P.sk1 = inl;
        for (int rep = 0; rep < (MK_DOUBLE == 2 ? 2 : 1); ++rep) g8::gemm_phase(stage, P, X.wave);
        RECTX(); convert_tiles8(X, 0, T8_WD, inl, 1 << 30);
        SEAM(2);
    }

    if (IN(3)) { RECTX(); p3_mix_prep(X); if (MK_DOUBLE == 3) { __syncthreads(); p3_mix_prep(X); } SEAM(3); }

    if (IN(4)) {
        g8::DenseP<0, false, 3> P{}; P.A = (const char*)(ws + E_VEVO); P.B = (const char*)(ws + WS_GT); P.C = (bf16_t*)(ws + E_QT);
        P.lda2 = 8192; P.ldb2 = 2048; P.nt = 8; P.nM = 256; P.nN = 2; P.G = X.G; P.c = X.bid; P.mPer = 32; P.bDiv = 2; P.ldc = 4096;
        P.aHi = 1024 * 2; P.aLo = 512 * 2; P.bHi = 512 * 1024 * 2; P.bLo = 512 * 2; P.cHi = 1024; P.cLo = 512; P.rowscale = nullptr; P.resid = nullptr;
        const int nun = X.bid < 512 ? (512 - X.bid + X.G - 1) / X.G : 0, per = X.bid < NT_WOUT ? (NT_WOUT - X.bid + X.G - 1) / X.G : 0, inl = min(per, nun * 8 / 8);
        P.ssrc0 = prm.in[I_WOUT]; P.ssrc1 = nullptr; P.sdst = ws + E_WOUTT; P.sbid = X.bid; P.sk1 = inl;
        for (int rep = 0; rep < (MK_DOUBLE == 4 ? 2 : 1); ++rep) g8::gemm_phase(stage, P, X.wave);
        RECTX(); convert_tiles8(X, NT_F8, T8_WOUT_END, inl, 1 << 30);
        if (X.bid < 16) {
            const int b = X.bid >> 2, h = X.bid & 3; const bf16_t* uv = (const bf16_t*)(ws + E_U) + (size_t)(b * SEQ + 2048) * DM + 2048 + h * 512;
            const bf16_t* gr = (const bf16_t*)(ws + WS_GT) + ((size_t)h * 512 + X.tid) * 1024; float a = 0.f;
            for (int k = 0; k < 512; k += 8) { const u32x4 x = *(const u32x4*)(uv + k), g = *(const u32x4*)(gr + k);
                a += bf_lo(x.x) * bf_lo(g.x) + bf_hi(x.x) * bf_hi(g.x) + bf_lo(x.y) * bf_lo(g.y) + bf_hi(x.y) * bf_hi(g.y) + bf_lo(x.z) * bf_lo(g.z) + bf_hi(x.z) * bf_hi(g.z) + bf_lo(x.w) * bf_lo(g.w) + bf_hi(x.w) * bf_hi(g.w); }
            ((bf16_t*)(ws + WS_PWT))[b * 2048 + h * 512 + X.tid] = (bf16_t)(cvt_pk_bf16(a, 0.f) & 0xffffu); }
        SEAM(4);
    }

    if (IN(5)) { RECTX();
        p5a_fft1(X);
        GRID_BAR();
        RECTX(); p5b_fft2(X);
        SEAM(5);
    }

    if (IN(6)) { RECTX();
        g8::DenseP<2, true, 2> P{}; P.A = (const char*)(ws + E_MIXED); P.B = (const char*)(ws + E_WOUTT); P.C = (bf16_t*)(ws + WS_H1B); P.C8 = ws + WS_H1F8; P.oscale = 1.0f / 64.0f;
        P.lda2 = 4096; P.ldb2 = 4096; P.nt = 32; P.nM = 64; P.nN = 16; P.G = X.G; P.c = X.bid; P.mPer = 64; P.bDiv = 1; P.ldc = 4096;
        P.aHi = 0; P.aLo = 0; P.bHi = 0; P.bLo = 0; P.cHi = 0; P.cLo = 0; P.rowscale = prm.in[I_G2]; P.resid = nullptr; P.residb = (const bf16_t*)(ws + E_XB);
        const int nun = X.bid < 64 * 16 ? (64 * 16 - X.bid + X.G - 1) / X.G : 0, per = X.bid < NT_EXP ? (NT_EXP - X.bid + X.G - 1) / X.G : 0, inl = min(per, nun * 32 / 8);
        P.ssrc0 = prm.in[I_WD]; P.ssrc1 = nullptr; P.sdst = ws + WS_WD; P.sbid = X.bid; P.sk1 = inl;
        for (int rep = 0; rep < (MK_DOUBLE == 6 ? 2 : 1); ++rep) g8::gemm_phase(stage, P, X.wave);
        RECTX(); convert_tiles8(X, T8_WD, NT_F8, inl, 1 << 30);
        SEAM(6);
    }

    if (IN(7)) { RECTX(); p7_router(X, 0, 0);
#if MK_DOUBLE == 7
        __syncthreads(); p7_router(X, E_U - WS_ROWTOK, 4096);
#endif
        SEAM(7); }

    if (IN(8)) { RECTX();
        const int T = moe_tables(X);
        g8::MoeGateUpP P{}; P.m0 = 0; P.nMv = T < 256 ? T : 256; P.A = (const char*)(ws + WS_H1F8); P.B = (const char*)(ws + WS_WGU); P.lda2 = 4096; P.ldb2 = 4096; P.nt = 32; P.G = X.G; P.c = X.bid;
        P.tab = (const int*)(ws + WS_TABG) + (size_t)X.bid * 2048; P.rowtok = (const int*)(ws + WS_ROWTOK); P.rowrstd = (const float*)(ws + WS_ROWRSTD);
        P.bgate = prm.in[I_BG]; P.bup = prm.in[I_BU]; P.act = ws + WS_ACT; P.preload();
        for (int rep = 0; rep < (MK_DOUBLE == 8 ? 2 : 1); ++rep) g8::gemm_phase(stage, P, X.wave);
        SEAM(8);
    }

    if (IN(9)) { RECTX();
        const int T = moe_tables(X);
        const int Lr = T > 256 ? T - 256 : 0;
        if (Lr > 0) {
            g8::MoeGateUpP P{}; P.m0 = 256; P.nMv = Lr; P.A = (const char*)(ws + WS_H1F8); P.B = (const char*)(ws + WS_WGU); P.lda2 = 4096; P.ldb2 = 4096; P.nt = 32; P.G = X.G; P.c = X.bid;
            P.tab = (const int*)(ws + WS_TABG) + (size_t)X.bid * 2048; P.rowtok = (const int*)(ws + WS_ROWTOK); P.rowrstd = (const float*)(ws + WS_ROWRSTD);
            P.bgate = prm.in[I_BG]; P.bup = prm.in[I_BU]; P.act = ws + WS_ACT; P.preload();
            g8::gemm_phase(stage, P, X.wave);
        }
        {   g8::MoeDownP P{}; P.mode = 0; P.nbusy = (4 * Lr < X.G) ? 4 * Lr : X.G; P.m0 = 0; P.nMv = T < 256 ? T : 256;
            P.A = (const char*)(ws + WS_ACT); P.B = (const char*)(ws + WS_WD); P.lda2 = 512; P.ldb2 = 512; P.nt = 4; P.G = X.G; P.c = X.bid;
            P.tab = (const int*)(ws + WS_TABG) + (size_t)X.bid * 2048; P.rowdst = (const int*)(ws + WS_ROWDST); P.rowgate = (const float*)(ws + WS_ROWGATE);
            P.bdown = prm.in[I_BD]; P.y = ws + E_Y; P.preload();
            for (int rep = 0; rep < (MK_DOUBLE == 9 ? 2 : 1); ++rep) g8::gemm_phase(stage, P, X.wave); }
        if (Lr > 0) {
            GRID_BAR();
            g8::MoeDownP P{}; P.mode = 1; P.nbusy = 0; P.m0 = 256; P.nMv = Lr;
            P.A = (const char*)(ws + WS_ACT); P.B = (const char*)(ws + WS_WD); P.lda2 = 512; P.ldb2 = 512; P.nt = 4; P.G = X.G; P.c = X.bid;
            P.tab = (const int*)(ws + WS_TABG) + (size_t)X.bid * 2048; P.rowdst = (const int*)(ws + WS_ROWDST); P.rowgate = (const float*)(ws + WS_ROWGATE);
            P.bdown = prm.in[I_BD]; P.y = ws + E_Y; P.preload();
            g8::gemm_phase(stage, P, X.wave);
        }
        SEAM(9);
    }

    if (IN(10)) { RECTX(); p10_combine(X); if (MK_DOUBLE == 10) { __syncthreads(); p10_combine(X); } }
#undef RECTX
#undef IN
#undef SEAM
#undef GRID_BAR
}

extern "C" void kernel_launch(void* const* d_in, const int* in_sizes, int n_in, void* d_out, int out_size, void* d_ws, size_t ws_size, hipStream_t stream) {
    static int grid = 0;
    if (grid == 0) {
        if (n_in != 17 || in_sizes[0] != NTOK * DM || out_size != NTOK * DM || ws_size < WS_END) { fprintf(stderr, "kernel_launch: unexpected shapes / workspace (n_in %d, ws %zu, need %zu); nothing launched\n", n_in, ws_size, (size_t)WS_END); grid = -1; return; }
        int dev = 0, cus = 0, per_cu = 0;
        if (hipGetDevice(&dev) != hipSuccess || hipDeviceGetAttribute(&cus, hipDeviceAttributeMultiprocessorCount, dev) != hipSuccess) { grid = -1; return; }
        if (hipFuncSetAttribute((const void*)mk_fwd, hipFuncAttributeMaxDynamicSharedMemorySize, LDS_BYTES) != hipSuccess) { fprintf(stderr, "kernel_launch: hipFuncSetAttribute failed\n"); grid = -1; return; }
        if (hipOccupancyMaxActiveBlocksPerMultiprocessor(&per_cu, (const void*)mk_fwd, NTHREADS, LDS_BYTES) != hipSuccess || per_cu < 1) { fprintf(stderr, "kernel_launch: occupancy query says %d\n", per_cu); (void)hipGetLastError(); per_cu = 1; }
        grid = cus;
    }
    if (grid < 0) return;
    if (hipMemsetAsync((char*)d_ws + WS_CTL, 0, CTL_BYTES, stream) != hipSuccess) return;
    Params a{};
    for (int i = 0; i < 17; ++i) a.in[i] = (const float*)d_in[i];
    a.out = (float*)d_out; a.ws = (unsigned char*)d_ws;
#if MK_PER_PHASE
    for (int ph = 0; ph < NPHASES; ++ph) { a.ph_lo = ph; a.ph_hi = ph + 1; hipLaunchKernelGGL(mk_fwd, dim3(grid), dim3(NTHREADS), LDS_BYTES, stream, a); }
#else
    a.ph_lo = 0; a.ph_hi = NPHASES;
    hipLaunchKernelGGL(mk_fwd, dim3(grid), dim3(NTHREADS), LDS_BYTES, stream, a);
#endif
}
```

```cpp
#include <hip/hip_runtime.h>
#include <stdio.h>
#include <stdint.h>

#ifndef MK_DOUBLE
#define MK_DOUBLE -1
#endif
#ifndef MK_PER_PHASE
#define MK_PER_PHASE 0
#endif
static_assert(MK_PER_PHASE == 0, "phases 5 and 9 synchronise inside the launch: build the one-launch form");

#define LAS __attribute__((address_space(3)))
typedef unsigned short bf16_t;
typedef short bf16x8 __attribute__((ext_vector_type(8)));
typedef float f32x4 __attribute__((ext_vector_type(4)));
typedef float f32x2 __attribute__((ext_vector_type(2)));
typedef unsigned u32x4 __attribute__((ext_vector_type(4)));
typedef unsigned u32x2 __attribute__((ext_vector_type(2)));

constexpr int DM = 4096, SEQ = 4096, NBATCH = 4, NTOK = NBATCH * SEQ;
constexpr int NE = 32, DFF = 512, CAP = 16384;
constexpr float RMS_EPS = 1e-5f;
constexpr int NTHREADS = 512, NPHASES = 11;

constexpr size_t MiB = 1ull << 20;
constexpr size_t WS_CTL = 0;
constexpr size_t CTL_BYTES = 65536;
constexpr size_t CTL_CNT = 16384;
constexpr size_t WS_RSTD1 = 65536;
constexpr size_t WS_ROWTOK = 1 * MiB;
constexpr size_t WS_ROWRSTD = 3 * MiB;
constexpr size_t WS_ROWGATE = 5 * MiB;
constexpr size_t WS_ROWDST = 7 * MiB;
constexpr size_t WS_PWT = 9 * MiB;
constexpr size_t WS_FWT = 11 * MiB;
constexpr size_t WS_DFTC = 13 * MiB;
constexpr size_t WS_GT = 14 * MiB;
constexpr size_t WS_RWT = 18 * MiB;
constexpr size_t WS_WGU = 20 * MiB;
constexpr size_t WS_WD = 148 * MiB;
constexpr size_t WS_H1B = 212 * MiB;
constexpr size_t WS_H1F8 = 340 * MiB;
constexpr size_t WS_ACT = 404 * MiB;
constexpr size_t WS_TABG = 437 * MiB;
constexpr size_t WS_E = 440 * MiB;
constexpr size_t E_XB = WS_E;
constexpr size_t E_MIXED = WS_E + 512 * MiB;
constexpr size_t E_WINT = WS_E + 128 * MiB;
constexpr size_t E_HM = E_WINT;
constexpr size_t E_WOUTT = WS_E + 160 * MiB;
constexpr size_t E_U = WS_E + 192 * MiB;
constexpr size_t E_VEVO = WS_E + 320 * MiB;
constexpr size_t E_QT = WS_E + 448 * MiB;
constexpr size_t E_T = E_U;
constexpr size_t E_WINP = E_QT;
constexpr size_t E_Y = WS_E;
constexpr size_t WS_END = WS_E + 640 * MiB;

constexpr int LDS_STAGE = 131072;
constexpr int LX_BAR = LDS_STAGE;
constexpr int LX_TAB = LDS_STAGE + 256;
constexpr int LX_RT = LDS_STAGE + 4096;
constexpr int LDS_BYTES = LDS_STAGE + 16384;

__device__ __forceinline__ unsigned cvt_pk_bf16(float lo, float hi) { unsigned r; asm("v_cvt_pk_bf16_f32 %0, %1, %2" : "=v"(r) : "v"(lo), "v"(hi)); return r; }
__device__ __forceinline__ float bf_lo(unsigned w) { return __uint_as_float(w << 16); }
__device__ __forceinline__ float bf_hi(unsigned w) { return __uint_as_float(w & 0xffff0000u); }
__device__ __forceinline__ u32x4 pack8(const f32x4 a, const f32x4 b) { u32x4 w; w.x = cvt_pk_bf16(a[0], a[1]); w.y = cvt_pk_bf16(a[2], a[3]); w.z = cvt_pk_bf16(b[0], b[1]); w.w = cvt_pk_bf16(b[2], b[3]); return w; }
__device__ __forceinline__ float wave_sum(float v) {
#pragma unroll
    for (int o = 32; o >= 1; o >>= 1) v += __shfl_xor(v, o);
    return v;
}

#define XB_TMO      128
#define XB_XCNT(j)  (256  + 64 * (j))
#define XB_XSUB(j)  (1280 + 64 * (j))
#define XB_XGEN(j)  (2304 + 64 * (j))
#define XB_TOP      3328
#define XB_TOPGEN   3392
#define XCD_BAR_WORDS 3456
#define XB_SPIN_CAP (1u << 18)
__device__ __forceinline__ unsigned xb_ld(unsigned* p)              { return __hip_atomic_load(p, __ATOMIC_RELAXED, __HIP_MEMORY_SCOPE_AGENT); }
__device__ __forceinline__ unsigned xb_add(unsigned* p, unsigned v) { return __hip_atomic_fetch_add(p, v, __ATOMIC_RELAXED, __HIP_MEMORY_SCOPE_AGENT); }
__device__ __forceinline__ unsigned xb_xcc_id() { return (unsigned)__builtin_amdgcn_s_getreg((3 << 11) | 20) & 0xFu; }
#define XB_SPIN(cond, bar) do { unsigned _sp = 0; while (cond) { __builtin_amdgcn_s_sleep(1); \
    if ((++_sp & 255u) == 0u) { if (xb_ld(&(bar)[XB_TMO])) break; if (_sp > XB_SPIN_CAP) { atomicAdd(&(bar)[XB_TMO], 1u); break; } } } } while (0)
struct XcdBarrier { unsigned* bar; unsigned x; volatile LAS unsigned* st; };
__device__ __forceinline__ XcdBarrier xcd_barrier_post(unsigned* bar, volatile LAS unsigned* st) {
    XcdBarrier b; b.bar = bar; b.x = xb_xcc_id(); b.st = st;
    if (threadIdx.x == 0) (void)xb_add(&bar[XB_XCNT(b.x)], 1u);
    return b;
}
__device__ __forceinline__ void xcd_barrier_complete(unsigned* bar, unsigned x, unsigned& nloc, unsigned& nx) {
    const unsigned G = gridDim.x * gridDim.y * gridDim.z;
    unsigned sum, cnt, mine, sp = 0u;
    for (;;) {
        sum = 0u; cnt = 0u; mine = 0u;
#pragma unroll
        for (unsigned j = 0; j < 16; ++j) { const unsigned c = xb_ld(&bar[XB_XCNT(j)]); sum += c; cnt += (c > 0u) ? 1u : 0u; mine = (j == x) ? c : mine; }
        if (sum == G) break;
        __builtin_amdgcn_s_sleep(1);
        if ((++sp & 255u) == 0u) { if (xb_ld(&bar[XB_TMO])) break; if (sp > XB_SPIN_CAP) { atomicAdd(&bar[XB_TMO], 1u); break; } }
    }
    nloc = mine > 0u ? mine : 1u; nx = cnt > 0u ? cnt : 1u;
}
__device__ __forceinline__ void xcd_barrier(const XcdBarrier& b, const bool leader) {
    asm volatile("s_waitcnt vmcnt(0)" ::: "memory");
    __syncthreads();
    if (leader) {
        unsigned* bar = b.bar;
        __builtin_amdgcn_s_waitcnt(0);
        unsigned nloc = b.st[0], nx = b.st[1];
        if (nloc == 0u) { xcd_barrier_complete(bar, b.x, nloc, nx); b.st[0] = nloc; b.st[1] = nx; }
        const unsigned old = xb_add(&bar[XB_XSUB(b.x)], 1u);
        const unsigned gen = old / nloc;
        if (old + 1u == (gen + 1u) * nloc) {
            __builtin_amdgcn_fence(__ATOMIC_RELEASE, "agent");
            asm volatile("s_waitcnt vmcnt(0)" ::: "memory");
            const unsigned og = xb_add(&bar[XB_TOP], 1u);
            const unsigned tg = og / nx;
            if (og + 1u == (tg + 1u) * nx) xb_add(&bar[XB_TOPGEN], 1u);
            else XB_SPIN(xb_ld(&bar[XB_TOPGEN]) == tg, bar);
            __builtin_amdgcn_fence(__ATOMIC_ACQUIRE, "agent");
            asm volatile("s_waitcnt vmcnt(0)" ::: "memory");
        } else {
            XB_SPIN(xb_ld(&bar[XB_TOPGEN]) == gen, bar);
            __builtin_amdgcn_fence(__ATOMIC_ACQUIRE, "agent");
            asm volatile("s_waitcnt vmcnt(0)" ::: "memory");
        }
    }
    __syncthreads();
}

namespace g8 {
constexpr int BM = 256, BK = 64, HALF = 128, HTB = HALF * BK * 2, NXCD = 8, WGM = 8;
__device__ __forceinline__ int lds_byte(int r, int c) { const int st = (r >> 4) * 2 + (c >> 5), rr = r & 15, cc = c & 31, ob = rr * 64 + cc * 2; return st * 1024 + (ob ^ (((ob >> 9) & 1) << 5)); }
__device__ __forceinline__ void stage_rc(int b, int& R, int& C) { const int st = b / 1024, sb = b % 1024, swz = sb ^ (((sb >> 9) & 1) << 5); R = (st >> 1) * 16 + swz / 64; C = (st & 1) * 32 + (swz % 64) / 2; }
__device__ __forceinline__ int perm32(int rho) { const int n = rho >> 4, i = rho & 15; return 8 * (i >> 2) + 4 * n + (i & 3); }

struct Unit { int pm, pn, e, mt, cnt, rb; };

__device__ __forceinline__ bool tile_of_L(long L, int nM, int nN, int& pm, int& pn) {
    const int nwg = nM * nN; if (L >= nwg) return false;
    int wgid = (int)L; { const int q = nwg / NXCD, r = nwg % NXCD, xcd = wgid % NXCD, off = wgid / NXCD; wgid = (xcd < r ? xcd * (q + 1) : r * (q + 1) + (xcd - r) * q) + off; }
    const int nig = WGM * nN, gid = wgid / nig, fm = gid * WGM, gsz = (nM - fm) < WGM ? (nM - fm) : WGM;
    pm = fm + ((wgid % nig) % gsz); pn = (wgid % nig) / gsz; return true;
}
__device__ __forceinline__ bool static_tile(int i, int G, int c, int nM, int nN, int& pm, int& pn) { return tile_of_L((long)i * G + c, nM, nN, pm, pn); }

typedef f32x4 Acc[2][2][4][2];
__device__ __forceinline__ int lane_id_v() { int l; asm volatile("v_mbcnt_lo_u32_b32 %0, -1, 0\n\tv_mbcnt_hi_u32_b32 %0, -1, %0" : "=&v"(l)); return l; }
typedef int i32x8 __attribute__((ext_vector_type(8)));
typedef int i32x4 __attribute__((ext_vector_type(4)));
__device__ __forceinline__ i32x8 cat8(bf16x8 a, bf16x8 b) { const i32x4 x = __builtin_bit_cast(i32x4, a), y = __builtin_bit_cast(i32x4, b); return __builtin_shufflevector(x, y, 0, 1, 2, 3, 4, 5, 6, 7); }
__device__ __forceinline__ u32x2 pack8_fp8(const f32x4 a, const f32x4 b) { int w0 = 0, w1 = 0;
    w0 = __builtin_amdgcn_cvt_pk_fp8_f32(a[0], a[1], w0, false); w0 = __builtin_amdgcn_cvt_pk_fp8_f32(a[2], a[3], w0, true);
    w1 = __builtin_amdgcn_cvt_pk_fp8_f32(b[0], b[1], w1, false); w1 = __builtin_amdgcn_cvt_pk_fp8_f32(b[2], b[3], w1, true);
    u32x2 r; r.x = (unsigned)w0; r.y = (unsigned)w1; return r; }

template <int N> __device__ __forceinline__ void wait_vm() { static_assert(N >= 0 && N < 64, "vmcnt is a 6-bit counter"); asm volatile("s_waitcnt vmcnt(%0)" :: "n"(N) : "memory"); }
template <class P>
__device__ __forceinline__ void gemm_phase(LAS unsigned char* lds, const P& p, const int wid) {
    constexpr int SX = P::STREAM != 0 ? 2 : 0;
    const int lane = (int)__builtin_amdgcn_mbcnt_hi(~0u, __builtin_amdgcn_mbcnt_lo(~0u, 0u)), tid = wid * 64 + lane, wr = wid >> 2, wc = wid & 3, fr = lane & 15, fq = lane >> 4;
    const int nt = p.nt;
    int Rr0, Cc0; stage_rc(tid * 16, Rr0, Cc0);
    const unsigned voffA = (unsigned)Rr0 * p.lda2 + (unsigned)Cc0 * 2u, voffB = (unsigned)(64 * (Rr0 >> 5) + 16 * ((Rr0 & 15) >> 2) + 4 * ((Rr0 >> 4) & 1) + (Rr0 & 3)) * p.ldb2 + (unsigned)Cc0 * 2u;
    const unsigned pstepA = 64u * p.lda2, pstepB = 128u * p.ldb2;
    const unsigned kstep = (unsigned)(BK * 2);
    const unsigned hstepA = (unsigned)HALF * p.lda2, hstepB = 8u * p.ldb2;
    const unsigned ldsw = ((unsigned)wid * 1024u) & 0x1c00u;
    const int aoff = lds_byte(wr * 64 + fr, fq * 8) & 0x3ff0, boff = lds_byte(wc * 32 + fr, fq * 8) & 0x3ff0;
    unsigned abase = (unsigned)(size_t)lds + (unsigned)aoff, bbase = (unsigned)(size_t)lds + 65536u + (unsigned)boff;
    int scale1 = 0x7f7f7f7f; asm volatile("" : "+v"(scale1));
    unsigned cvA[2][2], nvA[2][2];
    const __amdgpu_buffer_rsrc_t rsA = __builtin_amdgcn_make_buffer_rsrc((void*)p.A, (short)0, (int)0xFFFFFF00u, 0x00020000);
    const __amdgpu_buffer_rsrc_t rsB = __builtin_amdgcn_make_buffer_rsrc((void*)p.B, (short)0, (int)0xFFFFFF00u, 0x00020000);
#define G8_SA(b, h) (((b) * 2 + (h)) * HTB)
#define G8_SB(b, h) ((4 + (b) * 2 + (h)) * HTB)
#define G8_STAGE_B(bufoff, soff, h) do { const unsigned _so = (unsigned)(soff) + (unsigned)(h) * hstepB; _Pragma("unroll") for (int _i = 0; _i < 2; ++_i) \
        __builtin_amdgcn_raw_ptr_buffer_load_lds(rsB, (LAS void*)(lds + (bufoff) + ldsw + _i * 8192), 16, (int)voffB, (int)(_so + _i * pstepB), 0, 0); } while (0)
#define G8_STAGE_A(bufoff, soff, h, NX) do { \
        if constexpr (P::GATHER) { _Pragma("unroll") for (int _i = 0; _i < 2; ++_i) { const unsigned _o = (NX) ? nvA[h][_i] : cvA[h][_i]; \
            __builtin_amdgcn_raw_ptr_buffer_load_lds(rsA, (LAS void*)(lds + (bufoff) + ldsw + _i * 8192), 16, (int)_o, (int)(unsigned)(soff), 0, 0); } } \
        else { const unsigned _so = (unsigned)(soff) + (unsigned)(h) * hstepA; _Pragma("unroll") for (int _i = 0; _i < 2; ++_i) \
            __builtin_amdgcn_raw_ptr_buffer_load_lds(rsA, (LAS void*)(lds + (bufoff) + ldsw + _i * 8192), 16, (int)voffA, (int)(_so + _i * pstepA), 0, 0); } } while (0)
#define G8_FA(b, h, m, k) (*(const LAS bf16x8*)(lds + aoff + (G8_SA(b, h) + (m) * 2048 + (k) * 1024)))
#define G8_FB(b, h, n, k) (*(const LAS bf16x8*)(lds + boff + (G8_SB(b, h) + (n) * 2048 + (k) * 1024)))
#define G8_RD(dst, base, off) asm volatile("ds_read_b128 %0, %1 offset:%2" : "=v"(dst) : "v"(base), "i"(off))
#define G8_LDA(dst, b, h) do { _Pragma("unroll") for (int m = 0; m < 4; ++m) _Pragma("unroll") for (int k = 0; k < 2; ++k) { \
        if constexpr (P::FP8) G8_RD(dst[m][k], abase, G8_SA(b, h) + m * 2048 + k * 1024); else dst[m][k] = G8_FA(b, h, m, k); } } while (0)
#define G8_LDB(dst, b, h) do { _Pragma("unroll") for (int n = 0; n < 2; ++n) _Pragma("unroll") for (int k = 0; k < 2; ++k) { \
        if constexpr (P::FP8) G8_RD(dst[n][k], bbase, G8_SB(b, h) - 65536 + n * 2048 + k * 1024); else dst[n][k] = G8_FB(b, h, n, k); } } while (0)
#define G8_WAIT_L_AB() do { if constexpr (P::FP8) asm volatile("s_waitcnt lgkmcnt(0)" : "+v"(B0[0][0]), "+v"(B0[0][1]), "+v"(B0[1][0]), "+v"(B0[1][1]), "+v"(B1[0][0]), "+v"(B1[0][1]), "+v"(B1[1][0]), "+v"(B1[1][1]), \
            "+v"(At[0][0]), "+v"(At[0][1]), "+v"(At[1][0]), "+v"(At[1][1]), "+v"(At[2][0]), "+v"(At[2][1]), "+v"(At[3][0]), "+v"(At[3][1])); else G8_WAIT_L(0); } while (0)
#define G8_WAIT_L_A() do { if constexpr (P::FP8) asm volatile("s_waitcnt lgkmcnt(0)" : "+v"(At[0][0]), "+v"(At[0][1]), "+v"(At[1][0]), "+v"(At[1][1]), "+v"(At[2][0]), "+v"(At[2][1]), "+v"(At[3][0]), "+v"(At[3][1])); else G8_WAIT_L(0); } while (0)
#define G8_MMA(ai, bj, At, Bt) do { __builtin_amdgcn_s_setprio(1); _Pragma("unroll") for (int m = 0; m < 4; ++m) _Pragma("unroll") for (int n = 0; n < 2; ++n) { \
        if constexpr (P::FP8) asm volatile("v_mfma_scale_f32_16x16x128_f8f6f4 %0, %1, %2, %0, %3, %3 op_sel_hi:[0,0,0]" : "+v"(acc[ai][bj][m][n]) : "v"(cat8(Bt[n][0], Bt[n][1])), "v"(cat8(At[m][0], At[m][1])), "v"(scale1)); \
        else { _Pragma("unroll") for (int k = 0; k < 2; ++k) asm volatile("v_mfma_f32_16x16x32_bf16 %0, %1, %2, %0" : "+v"(acc[ai][bj][m][n]) : "v"(Bt[n][k]), "v"(At[m][k])); } } \
        __builtin_amdgcn_s_setprio(0); } while (0)
#define G8_MMA0(ai, bj, At, Bt) do { __builtin_amdgcn_s_setprio(1); _Pragma("unroll") for (int m = 0; m < 4; ++m) _Pragma("unroll") for (int n = 0; n < 2; ++n) { \
        if constexpr (P::FP8) asm volatile("v_mfma_scale_f32_16x16x128_f8f6f4 %0, %1, %2, 0, %3, %3 op_sel_hi:[0,0,0]" : "+v"(acc[ai][bj][m][n]) : "v"(cat8(Bt[n][0], Bt[n][1])), "v"(cat8(At[m][0], At[m][1])), "v"(scale1)); \
        else { asm volatile("v_mfma_f32_16x16x32_bf16 %0, %1, %2, 0" : "+v"(acc[ai][bj][m][n]) : "v"(Bt[n][0]), "v"(At[m][0])); \
               asm volatile("v_mfma_f32_16x16x32_bf16 %0, %1, %2, %0" : "+v"(acc[ai][bj][m][n]) : "v"(Bt[n][1]), "v"(At[m][1])); } } \
        __builtin_amdgcn_s_setprio(0); } while (0)
#define G8_MMAF(ai, bj, At, Bt, FIRST) do { if (FIRST) G8_MMA0(ai, bj, At, Bt); else G8_MMA(ai, bj, At, Bt); } while (0)
#define G8_WAIT_V(n) asm volatile("s_waitcnt vmcnt(" #n ")" ::: "memory")
#define G8_WAIT_L(n) asm volatile("s_waitcnt lgkmcnt(" #n ")" ::: "memory")
#define G8_BAR __builtin_amdgcn_s_barrier()
#define G8_SCHED __builtin_amdgcn_sched_barrier(0)
    Unit cur, nxt; int ui = 0;
    if (!p.next(0, cur)) return;
    int l2pf[1] = {0};
    unsigned strip = 0; int sacc[4] = {0, 0, 0, 0};
    Acc acc;
#pragma unroll
    for (int a = 0; a < 2; ++a)
#pragma unroll
        for (int b = 0; b < 2; ++b)
#pragma unroll
            for (int m = 0; m < 4; ++m)
#pragma unroll
                for (int n = 0; n < 2; ++n) acc[a][b][m][n] = (f32x4){0.f, 0.f, 0.f, 0.f};
    bf16x8 At[4][2], B0[2][2], B1[2][2];
    typename P::Pre pre;
    unsigned cA = __builtin_amdgcn_readfirstlane(p.a_off(cur)), cB = __builtin_amdgcn_readfirstlane(p.b_off(cur));
    if constexpr (P::GATHER) { p.a_rows(cur, wid, cvA); p.a_rows_fin(wid, cvA); asm volatile("" : "+v"(cvA[0][0]), "+v"(cvA[0][1]), "+v"(cvA[1][0]), "+v"(cvA[1][1])); }
    G8_STAGE_B(G8_SB(0, 0), cB, 0); G8_STAGE_B(G8_SB(0, 1), cB, 1); G8_STAGE_A(G8_SA(0, 0), cA, 0, false); G8_STAGE_A(G8_SA(0, 1), cA, 1, false);
    if (wr == 1) G8_BAR;
    G8_WAIT_V(2); G8_BAR;
    G8_STAGE_B(G8_SB(1, 0), cB + kstep, 0); G8_STAGE_A(G8_SA(1, 0), cA + kstep, 0, false); G8_STAGE_B(G8_SB(1, 1), cB + kstep, 1);
    G8_WAIT_V(6); G8_BAR;
    for (;;) {
        p.prefetch(cur, wid, pre);
        const bool has_next = p.next(ui + 1, nxt);
        const unsigned nA = __builtin_amdgcn_readfirstlane(has_next ? p.a_off(nxt) : cA), nB = __builtin_amdgcn_readfirstlane(has_next ? p.b_off(nxt) : cB);
        if constexpr (P::GATHER) { Unit ar; ar.pm = has_next ? nxt.pm : cur.pm; ar.pn = has_next ? nxt.pn : cur.pn; ar.e = has_next ? nxt.e : cur.e; ar.mt = has_next ? nxt.mt : cur.mt; ar.cnt = has_next ? nxt.cnt : cur.cnt; ar.rb = has_next ? nxt.rb : cur.rb;
            p.a_rows(ar, wid, nvA); }
#define G8_TRIP(TT, FIRST) do { \
            const int t = (TT); const bool last = (FIRST) ? false : (t == nt - 2);        \
            const unsigned a1 = cA + (unsigned)(t + 1) * kstep; \
            const unsigned a2 = last ? nA : cA + (unsigned)(t + 2) * kstep, b2 = last ? nB : cB + (unsigned)(t + 2) * kstep; \
            const unsigned a3 = a2 + kstep, b3 = b2 + kstep; \
            G8_LDB(B0, 0, 0); G8_LDB(B1, 0, 1); G8_SCHED; G8_LDA(At, 0, 0); G8_STAGE_A(G8_SA(1, 1), a1, 1, false); \
            f32x4 se0, se1; bool sval = false; int srq = 0, scc = 0, stI = 0; \
            if constexpr (P::STREAM != 0) { \
                const int sk = (int)(strip >> 2), sph = (int)(strip & 3u); \
                sval = sk < p.sk1; stI = sval ? p.sbid + sk * p.G : 0; \
                const int bi = wid * 2 + (sph >> 1); srq = (bi >> 2) * 8 + (lane >> 3); scc = (bi & 3) * 8 + (lane & 7); \
                const float* sp; int sld; \
                if constexpr (P::STREAM == 1) { const int q = stI & 4095, e = q >> 7, r = q & 127, kt = r >> 2, pn = r & 3; sld = 512; \
                    sp = (stI >= 4096 ? p.ssrc1 : p.ssrc0) + (size_t)e * 4096 * 512 + (size_t)kt * 128 * 512 + pn * 128; } \
                else { const int e = stI >> 7, r = stI & 127, ft = r >> 5, dt = r & 31; sld = 4096; \
                    sp = p.ssrc0 + (size_t)e * 512 * 4096 + (size_t)ft * 128 * 4096 + dt * 128; } \
                sp += (size_t)(4 * srq + 2 * (sph & 1)) * sld + scc * 4; \
                se0 = __builtin_nontemporal_load((const f32x4*)sp); se1 = __builtin_nontemporal_load((const f32x4*)(sp + sld)); \
            } \
            if (FIRST) { if (ui == 0) wait_vm<8 + SX + P::NPF>(); else wait_vm<8 + SX + P::NPF + P::NS>(); } else wait_vm<8 + SX>(); \
            G8_WAIT_L_AB(); G8_BAR; G8_MMAF(0, 0, At, B0, FIRST); G8_MMAF(0, 1, At, B1, FIRST); G8_BAR; G8_SCHED; \
            G8_LDA(At, 0, 1); G8_STAGE_B(G8_SB(0, 0), b2, 0); G8_STAGE_B(G8_SB(0, 1), b2, 1); G8_STAGE_A(G8_SA(0, 0), a2, 0, last); \
            if (FIRST) { if (ui == 0) wait_vm<8 + SX + P::NPF>(); else wait_vm<8 + SX + P::NPF + P::NS>(); } else wait_vm<8 + SX>(); \
            G8_WAIT_L_A(); G8_BAR; G8_MMAF(1, 0, At, B0, FIRST); G8_MMAF(1, 1, At, B1, FIRST); G8_BAR; G8_SCHED; \
            G8_LDB(B0, 1, 0); G8_LDB(B1, 1, 1); G8_SCHED; G8_LDA(At, 1, 0); G8_STAGE_A(G8_SA(0, 1), a2, 1, last); \
            wait_vm<8 + SX>(); \
            G8_WAIT_L_AB(); G8_BAR; G8_MMA(0, 0, At, B0); G8_MMA(0, 1, At, B1); G8_BAR; G8_SCHED; \
            G8_LDA(At, 1, 1); G8_STAGE_B(G8_SB(1, 0), b3, 0); G8_STAGE_B(G8_SB(1, 1), b3, 1); G8_STAGE_A(G8_SA(1, 0), a3, 0, last); \
            wait_vm<8>(); G8_WAIT_L_A(); G8_BAR; G8_MMA(1, 0, At, B0); G8_MMA(1, 1, At, B1); G8_BAR; G8_SCHED; \
            if constexpr (P::STREAM != 0) { \
                if ((strip & 1u) == 0) { \
                    _Pragma("unroll") for (int j = 0; j < 4; ++j) sacc[j] = __builtin_amdgcn_cvt_pk_fp8_f32(se0[j] * 64.f, se1[j] * 64.f, sacc[j], false); \
                } else { \
                    _Pragma("unroll") for (int j = 0; j < 4; ++j) sacc[j] = __builtin_amdgcn_cvt_pk_fp8_f32(se0[j] * 64.f, se1[j] * 64.f, sacc[j], true); \
                    if (sval) { \
                        unsigned char* dp; int dld; \
                        if constexpr (P::STREAM == 1) { const int q = stI & 4095, e = q >> 7, r = q & 127, kt = r >> 2, pn = r & 3; dld = 4096; \
                            dp = p.sdst + ((size_t)e * 1024 + pn * 256 + (stI >= 4096 ? 8 : 0) + 16 * (scc >> 1) + 4 * (scc & 1)) * 4096 + kt * 128 + 4 * srq; } \
                        else if constexpr (P::STREAM == 2) { const int e = stI >> 7, r = stI & 127, ft = r >> 5, dt = r & 31; dld = 512; \
                            dp = p.sdst + ((size_t)e * 4096 + dt * 128 + 4 * scc) * 512 + ft * 128 + 4 * srq; } \
                        else { const int kt = stI >> 5, nn = stI & 31; dld = 4096; \
                            dp = p.sdst + ((size_t)nn * 128 + 4 * scc) * 4096 + kt * 128 + 4 * srq; } \
                        _Pragma("unroll") for (int j = 0; j < 4; ++j) *(int*)(dp + (size_t)j * dld) = sacc[j]; \
                    } \
                } \
                ++strip; \
            } } while (0)
        G8_TRIP(0, true);
        if constexpr (P::L2PF) asm volatile("" :: "v"(l2pf[0]));
        if constexpr (P::GATHER) { asm volatile("" : "+v"(nvA[0][0]), "+v"(nvA[0][1]), "+v"(nvA[1][0]), "+v"(nvA[1][1])); p.a_rows_fin(wid, nvA); }
        for (int tq = 2; tq < nt; tq += 2) G8_TRIP(tq, false);
#undef G8_TRIP
        if (wr == 0) G8_BAR;
        if constexpr (P::L2PF) p.l2_prefetch(has_next, cur, nxt, ui, wid, l2pf);
        asm volatile("s_nop 15\n\ts_nop 15" ::: "memory");
        { const int lz = lane_id_v(); p.epi(acc, cur, wid >> 2, wid & 3, lz & 15, lz >> 4, pre); }
        if (!has_next) break;
        cur = nxt; cA = nA; cB = nB; ++ui;
        if constexpr (P::GATHER) { cvA[0][0] = nvA[0][0]; cvA[0][1] = nvA[0][1]; cvA[1][0] = nvA[1][0]; cvA[1][1] = nvA[1][1]; }
        if (wr == 1) G8_BAR;
    }
    G8_WAIT_V(0);
    G8_BAR;
#undef G8_SA
#undef G8_SB
#undef G8_STAGE_A
#undef G8_STAGE_B
#undef G8_LDA
#undef G8_FA
#undef G8_FB
#undef G8_RD
#undef G8_WAIT_L_AB
#undef G8_WAIT_L_A
#undef G8_LDB
#undef G8_MMA
#undef G8_MMA0
#undef G8_MMAF
#undef G8_WAIT_V
#undef G8_WAIT_L
#undef G8_BAR
#undef G8_SCHED
}

template <int EPI  , bool F8 = false, int STRM = 0> struct DenseP {
    static constexpr bool GATHER = false, FP8 = F8; static constexpr int SCALE_B = 0x7f7f7f7f;
    static constexpr bool L2PF = false; __device__ __forceinline__ void l2_prefetch(bool, const Unit&, const Unit&, int, int, int (&)[1]) const {}
    static constexpr int NPF = 0, NS = (EPI == 0 ? 16 : EPI == 1 ? 24 : 44);
    static constexpr int STREAM = STRM;
    const float* ssrc0; const float* ssrc1; unsigned char* sdst; int sbid, sk1; int pad2_[2];
    const char* A; const char* B; bf16_t* C; unsigned char* C8;
    unsigned lda2, ldb2; int nt, nM, nN, G, c, mPer, bDiv, ldc; float oscale; int pad_;
    size_t aHi, aLo, bHi, bLo, cHi, cLo;
    const float* rowscale; const float* resid; const bf16_t* residb;
    __device__ __forceinline__ bool next(int i, Unit& u) const { u.e = 0; u.mt = 0; u.cnt = 0; u.rb = 0; return static_tile(i, G, c, nM, nN, u.pm, u.pn); }
    __device__ __forceinline__ unsigned a_off(const Unit& u) const { const int batch = u.pm / mPer, mt = u.pm % mPer; return (unsigned)((size_t)(batch / bDiv) * aHi + (size_t)(batch % bDiv) * aLo + (size_t)mt * 256 * lda2); }
    __device__ __forceinline__ unsigned b_off(const Unit& u) const { const int batch = u.pm / mPer; return (unsigned)((size_t)(batch / bDiv) * bHi + (size_t)(batch % bDiv) * bLo + (size_t)u.pn * 256 * ldb2); }
    struct Pre {};
    __device__ __forceinline__ void prefetch(const Unit&, int, Pre&) const {}
    __device__ __forceinline__ void a_rows(const Unit&, int, unsigned (&)[2][2]) const {}
    __device__ __forceinline__ void a_rows_fin(int, unsigned (&)[2][2]) const {}
    __device__ __forceinline__ void epi(const Acc& acc, const Unit& u, int wr, int wc, int fr, int fq, const Pre&) const {
        const int batch = u.pm / mPer, mt = u.pm % mPer;
        const int row0 = mt * 256 + wr * 64 + fr, col0 = u.pn * 256 + wc * 64 + 16 * fq;
        bf16_t* base = C + (size_t)(batch / bDiv) * cHi + (size_t)(batch % bDiv) * cLo;
        float rsv[2][4];
#pragma unroll
        for (int ai = 0; ai < 2; ++ai)
#pragma unroll
            for (int m = 0; m < 4; ++m) rsv[ai][m] = (EPI == 1) ? rowscale[row0 + ai * 128 + m * 16] : 1.f;
        if constexpr (EPI == 2) {
            f32x4 cs8[2][2];
#pragma unroll
            for (int bj = 0; bj < 2; ++bj) { cs8[bj][0] = *(const f32x4*)(rowscale + col0 + bj * 8); cs8[bj][1] = *(const f32x4*)(rowscale + col0 + bj * 8 + 4); }
#pragma unroll
            for (int ai = 0; ai < 2; ++ai) {
                u32x4 rv[4][2];
#pragma unroll
                for (int m = 0; m < 4; ++m)
#pragma unroll
                    for (int bj = 0; bj < 2; ++bj) rv[m][bj] = *(const u32x4*)(residb + (size_t)(row0 + ai * 128 + m * 16) * ldc + col0 + bj * 8);
                __builtin_amdgcn_sched_barrier(0);
#pragma unroll
                for (int m = 0; m < 4; ++m) {
                    const int row = row0 + ai * 128 + m * 16;
                    u32x2 f8[2];
#pragma unroll
                    for (int bj = 0; bj < 2; ++bj) {
                        const u32x4 rw = rv[m][bj];
                        const f32x4 v0 = acc[ai][bj][m][0] * oscale + (f32x4){bf_lo(rw.x), bf_hi(rw.x), bf_lo(rw.y), bf_hi(rw.y)}, v1 = acc[ai][bj][m][1] * oscale + (f32x4){bf_lo(rw.z), bf_hi(rw.z), bf_lo(rw.w), bf_hi(rw.w)};
                        *(u32x4*)(base + (size_t)row * ldc + col0 + bj * 8) = pack8(v0, v1);
                        f8[bj] = pack8_fp8(v0 * cs8[bj][0], v1 * cs8[bj][1]);
                    }
                    *(u32x4*)(C8 + (size_t)row * ldc + col0) = (u32x4){f8[0].x, f8[0].y, f8[1].x, f8[1].y};
                }
                __builtin_amdgcn_sched_barrier(0);
            }
        } else {
#pragma unroll
        for (int ai = 0; ai < 2; ++ai)
#pragma unroll
            for (int m = 0; m < 4; ++m) {
                const int row = row0 + ai * 128 + m * 16;
                const float rs = rsv[ai][m];
#pragma unroll
                for (int bj = 0; bj < 2; ++bj) {
                    f32x4 v0 = acc[ai][bj][m][0], v1 = acc[ai][bj][m][1];
                    if (EPI == 1) { v0 *= rs; v1 *= rs; }
                    *(u32x4*)(base + (size_t)row * ldc + col0 + bj * 8) = pack8(v0, v1);
                }
            }
        }
    }
};

#define TABU(x) __builtin_amdgcn_readfirstlane(x)
__device__ __forceinline__ void moe_rec(LAS const int* tab, Unit& u) {
    const i32x4 r = *(LAS const i32x4*)(tab + 4 + 4 * u.pm);
    u.e = TABU(r.x); u.mt = TABU(r.y); u.cnt = TABU(r.z); u.rb = TABU(r.w); }
struct MoeGateUpP {
    static constexpr bool GATHER = true, FP8 = true; static constexpr int SCALE_B = 0x7f7f7f7f, STREAM = 0, NPF = 12  , NS = 12  ;
    static constexpr bool L2PF = false; __device__ __forceinline__ void l2_prefetch(bool, const Unit&, const Unit&, int, int, int (&)[1]) const {}
    const char* A; const char* B; unsigned lda2, ldb2; int nt, G, c;
    LAS const int* tab; int m0, nMv;
    const int* rowtok; const float* rowrstd; const float* bgate; const float* bup; unsigned char* act;
    i32x4 lrec; int lpp;
    __device__ __forceinline__ bool unit_tile(int i, int& pm, int& pn) const { if (!static_tile(i, G, c, nMv, 4, pm, pn)) return false; pm += m0; return true; }
    __device__ __forceinline__ void preload() { const int lz = lane_id_v(); int pm, pn; lrec = (i32x4){0, 0, 0, 0}; lpp = -1;
        if (unit_tile(lz, pm, pn)) { lrec = *(LAS const i32x4*)(tab + 4 + 4 * pm); lpp = pm | (pn << 16); } }
    __device__ __forceinline__ bool next(int i, Unit& u) const {
        if (i < 64) { const int pp = __builtin_amdgcn_readlane(lpp, i); if (pp < 0) return false; u.pm = pp & 0xffff; u.pn = pp >> 16;
            u.e = __builtin_amdgcn_readlane(lrec.x, i); u.mt = __builtin_amdgcn_readlane(lrec.y, i); u.cnt = __builtin_amdgcn_readlane(lrec.z, i); u.rb = __builtin_amdgcn_readlane(lrec.w, i); return true; }
        if (!unit_tile(i, u.pm, u.pn)) return false; moe_rec(tab, u); return true; }
    __device__ __forceinline__ unsigned a_off(const Unit&) const { return 0u; }
    __device__ __forceinline__ unsigned b_off(const Unit& u) const { return (unsigned)(((size_t)u.e * 1024 + (size_t)u.pn * 256) * ldb2); }
    __device__ __forceinline__ void a_rows(const Unit& u, int wid, unsigned (&v)[2][2]) const {
        const int cnt = u.cnt;
        const int tz = wid * 64 + lane_id_v(); int Rr[2], Cc[2]; stage_rc(tz * 16, Rr[0], Cc[0]); stage_rc(tz * 16 + 8192, Rr[1], Cc[1]);
#pragma unroll
        for (int h = 0; h < 2; ++h)
#pragma unroll
            for (int i = 0; i < 2; ++i) { const int pos = min(u.mt * 256 + h * 128 + Rr[i], cnt - 1); v[h][i] = (unsigned)rowtok[u.e * CAP + pos]; }
    }
    __device__ __forceinline__ void a_rows_fin(int wid, unsigned (&v)[2][2]) const {
        const int tz = wid * 64 + lane_id_v(); int Rr[2], Cc[2]; stage_rc(tz * 16, Rr[0], Cc[0]); stage_rc(tz * 16 + 8192, Rr[1], Cc[1]);
#pragma unroll
        for (int h = 0; h < 2; ++h)
#pragma unroll
            for (int i = 0; i < 2; ++i) v[h][i] = v[h][i] * lda2 + (unsigned)Cc[i] * 2u;
    }
    struct Pre { float rs[2][4]; };
    __device__ __forceinline__ void prefetch(const Unit& u, int wid, Pre& q) const {
        const int lz = lane_id_v(), wr = wid >> 2, fr = lz & 15;
#pragma unroll
        for (int ai = 0; ai < 2; ++ai)
#pragma unroll
            for (int m = 0; m < 4; ++m) { const int pos = min(u.mt * 256 + ai * 128 + wr * 64 + m * 16 + fr, u.cnt - 1); q.rs[ai][m] = rowrstd[u.e * CAP + pos]; }
    }
    __device__ __forceinline__ void epi(const Acc& acc, const Unit& u, int wr, int wc, int fr, int fq, const Pre& q) const {
        const int cnt = u.cnt, rb = u.rb;
        const int f0 = u.pn * 128 + wc * 32 + 8 * fq;
        const f32x4 bg0 = *(const f32x4*)(bgate + u.e * DFF + f0), bg1 = *(const f32x4*)(bgate + u.e * DFF + f0 + 4);
        const f32x4 bu0 = *(const f32x4*)(bup + u.e * DFF + f0) + 1.0f, bu1 = *(const f32x4*)(bup + u.e * DFF + f0 + 4) + 1.0f;
        float rsv[2][4];
#pragma unroll
        for (int ai = 0; ai < 2; ++ai)
#pragma unroll
            for (int m = 0; m < 4; ++m) rsv[ai][m] = q.rs[ai][m] * (1.0f / 64.0f);
        asm volatile("" :: "v"(rsv[0][0]), "v"(rsv[0][1]), "v"(rsv[0][2]), "v"(rsv[0][3]), "v"(rsv[1][0]), "v"(rsv[1][1]), "v"(rsv[1][2]), "v"(rsv[1][3]), "v"(bg0), "v"(bg1), "v"(bu0), "v"(bu1));
#pragma unroll
        for (int ai = 0; ai < 2; ++ai)
#pragma unroll
            for (int m = 0; m < 4; ++m) {
                const int pos = u.mt * 256 + ai * 128 + wr * 64 + m * 16 + fr;
                {
                    const float rs = rsv[ai][m];
                    f32x4 o[2];
#pragma unroll
                    for (int n = 0; n < 2; ++n) {
                        const f32x4 g = acc[ai][0][m][n] * rs + (n ? bg1 : bg0), up = acc[ai][1][m][n] * rs + (n ? bu1 : bu0);
                        f32x4 hg, hu, e, sg;
#pragma unroll
                        for (int j = 0; j < 4; ++j) { hg[j] = fminf(g[j], 7.0f); hu[j] = fminf(fmaxf(up[j], -6.0f), 8.0f); }
                        const f32x4 t = hg * (-1.702f * 1.44269504f);
#pragma unroll
                        for (int j = 0; j < 4; ++j) e[j] = __builtin_amdgcn_exp2f(t[j]);
                        const f32x4 d = e + 1.0f;
#pragma unroll
                        for (int j = 0; j < 4; ++j) sg[j] = __builtin_amdgcn_rcpf(d[j]);
                        o[n] = hg * sg * hu;
                    }
                    *(u32x2*)(act + (size_t)(pos < cnt ? rb + pos : NTOK * 4) * DFF + f0) = pack8_fp8(o[0], o[1]);
                }
            }
    }
};
struct MoeDownP {
    static constexpr bool GATHER = false, FP8 = true; static constexpr int SCALE_B = 0x7f7f7f7f, STREAM = 0, NPF = 20  , NS = 9  ;
    static constexpr bool L2PF = true;
    const char* A; const char* B; unsigned lda2, ldb2; int nt, G, c;
    LAS const int* tab; int mode, nbusy, m0, nMv;
    const int* rowdst; const float* rowgate; const float* bdown; unsigned char* y;
    i32x4 lrec; int lpp;
    __device__ __forceinline__ bool unit_tile(int i, int& pm, int& pn) const {
        if (mode == 1) { if (!static_tile(i, G, c, nMv, 16, pm, pn)) return false; pm += m0; }
        else { const int nfree = G - nbusy; long idx;
            if (c >= nbusy) idx = (i < 4) ? (long)i * nfree + (c - nbusy) : 4l * nfree + (long)(i - 4) * G + c;
            else idx = 4l * nfree + (long)i * G + c;
            if (!tile_of_L(idx, nMv, 16, pm, pn)) return false; }
        return true; }
    __device__ __forceinline__ void preload() { const int lz = lane_id_v(); int pm, pn; lrec = (i32x4){0, 0, 0, 0}; lpp = -1;
        if (unit_tile(lz, pm, pn)) { lrec = *(LAS const i32x4*)(tab + 4 + 4 * pm); lpp = pm | (pn << 16); } }
    __device__ __forceinline__ bool next(int i, Unit& u) const {
        if (i < 64) { const int pp = __builtin_amdgcn_readlane(lpp, i); if (pp < 0) return false; u.pm = pp & 0xffff; u.pn = pp >> 16;
            u.e = __builtin_amdgcn_readlane(lrec.x, i); u.mt = __builtin_amdgcn_readlane(lrec.y, i); u.cnt = __builtin_amdgcn_readlane(lrec.z, i); u.rb = __builtin_amdgcn_readlane(lrec.w, i); return true; }
        if (!unit_tile(i, u.pm, u.pn)) return false; moe_rec(tab, u); return true; }
    __device__ __forceinline__ unsigned a_off(const Unit& u) const { return (unsigned)((size_t)(u.rb + u.mt * 256) * lda2); }
    __device__ __forceinline__ void l2_prefetch(bool has_next, const Unit& cur, const Unit& nxt, int, int wid, int (&v)[1]) const {
        const int e1 = has_next ? nxt.e : cur.e, pn1 = has_next ? nxt.pn : cur.pn;
        const int tz = wid * 64 + lane_id_v(); const unsigned ro = (unsigned)(tz >> 1) * 512u + (unsigned)(tz & 1) * 128u + 256u;
        const char* b1 = B + ((size_t)((size_t)e1 * 4096 + (size_t)pn1 * 256) * ldb2 + ro);
        asm volatile("global_load_dword %0, %1, off" : "=v"(v[0]) : "v"(b1) : "memory");
    }
    __device__ __forceinline__ unsigned b_off(const Unit& u) const { return (unsigned)(((size_t)u.e * 4096 + (size_t)u.pn * 256) * ldb2); }
    __device__ __forceinline__ void a_rows(const Unit&, int, unsigned (&)[2][2]) const {}
    __device__ __forceinline__ void a_rows_fin(int, unsigned (&)[2][2]) const {}
    struct Pre { float gw[2][4]; int ds[2][4]; f32x4 bd[2][2]; };
    __device__ __forceinline__ void prefetch(const Unit& u, int wid, Pre& q) const {
        const int lz = lane_id_v(), wr = wid >> 2, fr = lz & 15;
        {   const int c0 = u.pn * 256 + (wid & 3) * 64 + 16 * (lz >> 4);
#pragma unroll
            for (int bj = 0; bj < 2; ++bj) { q.bd[bj][0] = *(const f32x4*)(bdown + (size_t)u.e * DM + c0 + bj * 8); q.bd[bj][1] = *(const f32x4*)(bdown + (size_t)u.e * DM + c0 + bj * 8 + 4); } }
#pragma unroll
        for (int ai = 0; ai < 2; ++ai)
#pragma unroll
            for (int m = 0; m < 4; ++m) { const int pos = min(u.mt * 256 + ai * 128 + wr * 64 + m * 16 + fr, u.cnt - 1); q.gw[ai][m] = rowgate[u.e * CAP + pos]; q.ds[ai][m] = rowdst[u.e * CAP + pos]; }
    }
    __device__ __forceinline__ void epi(const Acc& acc, const Unit& u, int wr, int wc, int fr, int fq, const Pre& q) const {
        const int cnt = u.cnt;
        const int c0 = u.pn * 256 + wc * 64 + 16 * fq;
        f32x4 bd[2][2];
#pragma unroll
        for (int bj = 0; bj < 2; ++bj) { bd[bj][0] = q.bd[bj][0]; bd[bj][1] = q.bd[bj][1]; }
        asm volatile("" :: "v"(bd[0][0]), "v"(bd[0][1]), "v"(bd[1][0]), "v"(bd[1][1]));
        float gwv[2][4]; int dsv[2][4];
#pragma unroll
        for (int ai = 0; ai < 2; ++ai)
#pragma unroll
            for (int m = 0; m < 4; ++m) { gwv[ai][m] = q.gw[ai][m] * 8.0f; dsv[ai][m] = q.ds[ai][m]; }
        asm volatile("" :: "v"(gwv[0][0]), "v"(gwv[0][1]), "v"(gwv[0][2]), "v"(gwv[0][3]), "v"(gwv[1][0]), "v"(gwv[1][1]), "v"(gwv[1][2]), "v"(gwv[1][3]), "v"(dsv[0][0]), "v"(dsv[0][1]), "v"(dsv[0][2]), "v"(dsv[0][3]), "v"(dsv[1][0]), "v"(dsv[1][1]), "v"(dsv[1][2]), "v"(dsv[1][3]), "v"(bd[0][0]), "v"(bd[0][1]), "v"(bd[1][0]), "v"(bd[1][1]));
#pragma unroll
        for (int ai = 0; ai < 2; ++ai)
#pragma unroll
            for (int m = 0; m < 4; ++m) {
                const int pos = u.mt * 256 + ai * 128 + wr * 64 + m * 16 + fr;
                {
                    const float gw = gwv[ai][m]; const int dst = pos < cnt ? dsv[ai][m] : NTOK * 4;
                    u32x2 f8[2];
#pragma unroll
                    for (int bj = 0; bj < 2; ++bj) {
                        const f32x4 v0 = (acc[ai][bj][m][0] * (1.0f / 64.0f) + bd[bj][0]) * gw, v1 = (acc[ai][bj][m][1] * (1.0f / 64.0f) + bd[bj][1]) * gw;
                        f8[bj] = pack8_fp8(v0, v1);
                    }
                    *(u32x4*)(y + (size_t)dst * DM + c0) = (u32x4){f8[0].x, f8[0].y, f8[1].x, f8[1].y};
                }
            }
    }
};
}

struct Params { const float* in[17]; float* out; unsigned char* ws; int ph_lo, ph_hi; };
enum { I_X = 0, I_G1, I_WIN, I_POOLW, I_POOLS, I_FW, I_WOUT, I_G2, I_RW, I_RB, I_WG, I_BG, I_WU, I_BU, I_WD, I_BD, I_GF };

struct Ctx { const Params* p; LAS unsigned char* lds; int tid, lane, wave, G, bid; };

struct TileD { const float* src; bf16_t* dst; const float* rs; const float* cs; int lds_, ldd; float mul; int perm; };
constexpr int NT_WINF = 512, NT_WOUT = 1024, NT_EXP = 4096, NT_SMALL = 64;
constexpr int T0_WOUT = NT_WINF, T0_PW = T0_WOUT, T0_FW = T0_PW + NT_SMALL, NT_BF = T0_FW + NT_SMALL;
constexpr int T8_WU = NT_EXP, T8_WD = 2 * NT_EXP, NT_F8 = 3 * NT_EXP, T8_WOUT_END = NT_F8 + NT_WOUT;
__device__ __forceinline__ TileD tile_desc(const Params& p, int t) {
    TileD d; d.rs = nullptr; d.cs = nullptr; d.mul = 1.f; d.perm = 0;
    unsigned char* ws = p.ws;
    if (t < T0_WOUT) { const int kt = t / 16, n = t % 16;
        d.src = p.in[I_WIN] + (size_t)kt * 128 * 4096 + 2048 + n * 128; d.lds_ = 4096; d.dst = (bf16_t*)(ws + E_WINT) + (size_t)(2048 + n * 128) * 4096 + kt * 128; d.ldd = 4096; d.rs = p.in[I_G1] + kt * 128;
    } else if (t < T0_FW) { const int q = t - T0_PW, g = q / 16, r = q % 16, jt = r / 4, n = r % 4;
        d.src = p.in[I_POOLW] + (size_t)g * 512 * 512 + (size_t)jt * 128 * 512 + n * 128; d.lds_ = 512; d.dst = (bf16_t*)(ws + WS_PWT) + (size_t)g * 512 * 512 + (size_t)(n * 128) * 512 + jt * 128; d.ldd = 512; d.cs = p.in[I_POOLS] + g * 512 + n * 128;
    } else { const int q = t - T0_FW, g = q / 16, r = q % 16, jt = r / 4, n = r % 4;
        d.src = p.in[I_FW] + (size_t)g * 512 * 512 + (size_t)jt * 128 * 512 + n * 128; d.lds_ = 512; d.dst = (bf16_t*)(ws + WS_FWT) + (size_t)g * 512 * 512 + (size_t)(n * 128) * 512 + jt * 128; d.ldd = 512;
    }
    return d;
}
__device__ __forceinline__ TileD tile_desc8(const Params& p, int t) {
    TileD d; d.rs = nullptr; d.cs = nullptr; d.mul = 64.f; d.perm = 0;
    unsigned char* ws = p.ws;
    if (t < T8_WD) { const bool up = t >= T8_WU; const int q = t - (up ? T8_WU : 0), e = q / 128, r = q % 128, kt = r / 4, pn = r % 4;
        d.src = p.in[up ? I_WU : I_WG] + (size_t)e * 4096 * 512 + (size_t)kt * 128 * 512 + pn * 128; d.lds_ = 512;
        d.dst = (bf16_t*)(ws + WS_WGU + ((size_t)e * 1024 + pn * 256 + (up ? 8 : 0)) * 4096 + kt * 128); d.ldd = 4096; d.perm = 1;
    } else if (t < NT_F8) { const int q = t - T8_WD, e = q / 128, r = q % 128, ft = r / 32, dt = r % 32;
        d.src = p.in[I_WD] + (size_t)e * 512 * 4096 + (size_t)ft * 128 * 4096 + dt * 128; d.lds_ = 4096; d.dst = (bf16_t*)(ws + WS_WD + ((size_t)e * 4096 + dt * 128) * 512 + ft * 128); d.ldd = 512;
    } else { const int q = t - NT_F8, kt = q / 32, nn = q % 32;
        d.src = p.in[I_WOUT] + (size_t)kt * 128 * 4096 + nn * 128; d.lds_ = 4096; d.dst = (bf16_t*)(ws + E_WOUTT + (size_t)(nn * 128) * 4096 + kt * 128); d.ldd = 4096;
    }
    return d;
}
constexpr int TP8_PITCH = 144;
__device__ __forceinline__ void tile8_load(const TileD& d, int wave, int lane, f32x4 (&v)[2][4], float (&rs)[2][4]) {
#pragma unroll
    for (int i = 0; i < 2; ++i) { const int bi = wave * 2 + i, rq = (bi >> 2) * 8 + (lane >> 3), cc = (bi & 3) * 8 + (lane & 7);
        const float* s = d.src + (size_t)(4 * rq) * d.lds_ + cc * 4;
#pragma unroll
        for (int r = 0; r < 4; ++r) { v[i][r] = __builtin_nontemporal_load((const f32x4*)(s + (size_t)r * d.lds_)); rs[i][r] = (d.rs ? d.rs[4 * rq + r] : 1.f) * d.mul; } }
}
__device__ __forceinline__ void tile8_to_lds(LAS unsigned char* tl, int wave, int lane, const f32x4 (&v)[2][4], const float (&rs)[2][4]) {
#pragma unroll
    for (int i = 0; i < 2; ++i) { const int bi = wave * 2 + i, rq = (bi >> 2) * 8 + (lane >> 3), cc = (bi & 3) * 8 + (lane & 7);
#pragma unroll
        for (int j = 0; j < 4; ++j) { int w = 0; w = __builtin_amdgcn_cvt_pk_fp8_f32(v[i][0][j] * rs[i][0], v[i][1][j] * rs[i][1], w, false); w = __builtin_amdgcn_cvt_pk_fp8_f32(v[i][2][j] * rs[i][2], v[i][3][j] * rs[i][3], w, true);
            *(LAS int*)(tl + (cc * 4 + j) * TP8_PITCH + rq * 4) = w; } }
}
__device__ __forceinline__ void tile8_store(const TileD& d, const LAS unsigned char* tl, int tid) {
#pragma unroll
    for (int i = 0; i < 2; ++i) { const int q = tid + 512 * i, c = q >> 3, ch = q & 7;
        const u32x4 w = *(const LAS u32x4*)(tl + c * TP8_PITCH + ch * 16);
        const int cr = d.perm ? ((c >> 3) * 16 + (c & 7)) : c;
        __builtin_nontemporal_store(w, (u32x4*)((unsigned char*)d.dst + (size_t)cr * d.ldd + ch * 16)); }
}
constexpr int TP_PITCH = 272;
__device__ __forceinline__ void tile_load(const TileD& d, int wave, int lane, f32x4 (&v)[4][2], float (&rs)[4][2], f32x4 (&cs)[4]) {
#pragma unroll
    for (int i = 0; i < 4; ++i) { const int bi = wave * 4 + i, rp = (bi >> 2) * 8 + (lane >> 3), cc = (bi & 3) * 8 + (lane & 7);
        const float* s = d.src + (size_t)(2 * rp) * d.lds_ + cc * 4;
        v[i][0] = __builtin_nontemporal_load((const f32x4*)s); v[i][1] = __builtin_nontemporal_load((const f32x4*)(s + d.lds_));
        rs[i][0] = d.rs ? d.rs[2 * rp] : 1.f; rs[i][1] = d.rs ? d.rs[2 * rp + 1] : 1.f;
        cs[i] = d.cs ? *(const f32x4*)(d.cs + cc * 4) : (f32x4){1.f, 1.f, 1.f, 1.f}; }
}
__device__ __forceinline__ void tile_to_lds(LAS unsigned char* tl, int wave, int lane, const f32x4 (&v)[4][2], const float (&rs)[4][2], const f32x4 (&cs)[4]) {
#pragma unroll
    for (int i = 0; i < 4; ++i) { const int bi = wave * 4 + i, rp = (bi >> 2) * 8 + (lane >> 3), cc = (bi & 3) * 8 + (lane & 7);
#pragma unroll
        for (int j = 0; j < 4; ++j) *(LAS unsigned*)(tl + (cc * 4 + j) * TP_PITCH + rp * 4) = cvt_pk_bf16(v[i][0][j] * rs[i][0] * cs[i][j], v[i][1][j] * rs[i][1] * cs[i][j]); }
}
__device__ __forceinline__ void tile_store(const TileD& d, const LAS unsigned char* tl, int tid) {
#pragma unroll
    for (int i = 0; i < 4; ++i) { const int q = tid + 512 * i, c = q >> 4, ch = q & 15;
        const u32x4 w = *(const LAS u32x4*)(tl + c * TP_PITCH + ch * 16);
        *(u32x4*)(d.dst + (size_t)c * d.ldd + ch * 8) = w; }
}
__device__ __forceinline__ void convert_tiles8(const Ctx& X, const int tb, const int te, const int k0, const int k1) {
    const Params& p = *X.p;
    f32x4 vA[2][4], vB[2][4]; float rA[2][4], rB[2][4];
    const int step = 2 * X.G;
    int t0 = tb + X.bid + k0 * X.G, t1 = t0 + X.G;
    const long tlim = (long)tb + X.bid + (long)k1 * X.G; const int tend = (int)(tlim < te ? tlim : te);
    TileD dA, dB;
    if (t0 < tend) { dA = tile_desc8(p, t0); tile8_load(dA, X.wave, X.lane, vA, rA); }
    if (t1 < tend) { dB = tile_desc8(p, t1); tile8_load(dB, X.wave, X.lane, vB, rB); }
    LAS unsigned char* tl0 = X.lds; LAS unsigned char* tl1 = X.lds + 128 * TP8_PITCH;
    while (t0 < tend) {
        tile8_to_lds(tl0, X.wave, X.lane, vA, rA);
        const TileD d0 = dA; if (t0 + step < tend) { dA = tile_desc8(p, t0 + step); tile8_load(dA, X.wave, X.lane, vA, rA); }
        __syncthreads();
        tile8_store(d0, tl0, X.tid);
        if (t1 < tend) {
            tile8_to_lds(tl1, X.wave, X.lane, vB, rB);
            const TileD d1 = dB; if (t1 + step < tend) { dB = tile_desc8(p, t1 + step); tile8_load(dB, X.wave, X.lane, vB, rB); }
            __syncthreads();
            tile8_store(d1, tl1, X.tid);
        }
        t0 += step; t1 += step;
    }
    __syncthreads();
}
__device__ __forceinline__ void p0_prep(const Ctx& X) {
    const Params& p = *X.p; unsigned char* ws = p.ws;
    const int gw = X.bid * 8 + X.wave, NGW = X.G * 8, gt = X.bid * NTHREADS + X.tid, NGT = X.G * NTHREADS;
    {   const float* x = p.in[I_X]; bf16_t* xb = (bf16_t*)(ws + E_XB); float* rstd = (float*)(ws + WS_RSTD1);
        for (int r = gw; r < NTOK; r += NGW) {
            const float* xr = x + (size_t)r * DM; f32x4 v[8][2]; float ss = 0.f;
#pragma unroll
            for (int i = 0; i < 8; ++i) { const int c = (i * 64 + X.lane) * 8; v[i][0] = __builtin_nontemporal_load((const f32x4*)(xr + c)); v[i][1] = __builtin_nontemporal_load((const f32x4*)(xr + c + 4)); }
#pragma unroll
            for (int i = 0; i < 8; ++i) {
#pragma unroll
                for (int j = 0; j < 4; ++j) ss += v[i][0][j] * v[i][0][j] + v[i][1][j] * v[i][1][j];
                *(u32x4*)(xb + (size_t)r * DM + (i * 64 + X.lane) * 8) = pack8(v[i][0], v[i][1]); }
            ss = wave_sum(ss);
            if (X.lane == 0) rstd[r] = rsqrtf(ss * (1.0f / DM) + RMS_EPS);
        }
    }
    {   f32x4 vA[4][2], vB[4][2]; float rA[4][2], rB[4][2]; f32x4 cA[4], cB[4];
        int t0 = X.bid, t1 = X.bid + X.G; const int step = 2 * X.G;
        TileD dA, dB;
        if (t0 < NT_BF) { dA = tile_desc(p, t0); tile_load(dA, X.wave, X.lane, vA, rA, cA); }
        if (t1 < NT_BF) { dB = tile_desc(p, t1); tile_load(dB, X.wave, X.lane, vB, rB, cB); }
        LAS unsigned char* tl0 = X.lds; LAS unsigned char* tl1 = X.lds + 128 * TP_PITCH;
        while (t0 < NT_BF) {
            tile_to_lds(tl0, X.wave, X.lane, vA, rA, cA);
            const TileD d0 = dA; if (t0 + step < NT_BF) { dA = tile_desc(p, t0 + step); tile_load(dA, X.wave, X.lane, vA, rA, cA); }
            __syncthreads();
            tile_store(d0, tl0, X.tid);
            if (t1 < NT_BF) {
                tile_to_lds(tl1, X.wave, X.lane, vB, rB, cB);
                const TileD d1 = dB; if (t1 + step < NT_BF) { dB = tile_desc(p, t1 + step); tile_load(dB, X.wave, X.lane, vB, rB, cB); }
                __syncthreads();
                tile_store(d1, tl1, X.tid);
            }
            t0 += step; t1 += step;
        }
        __syncthreads();
    }
    {   const float* w = p.in[I_WIN]; const float* g1 = p.in[I_G1]; bf16_t* o = (bf16_t*)(ws + E_WINP);
        for (int it = gt; it < 4096 * 256; it += NGT) { const int k = it >> 8, j = (it & 255) * 8; const float g = g1[k];
            const f32x4 a = __builtin_nontemporal_load((const f32x4*)(w + (size_t)k * 4096 + j)) * g, b = __builtin_nontemporal_load((const f32x4*)(w + (size_t)k * 4096 + j + 4)) * g;
            *(u32x4*)(o + (size_t)k * 2048 + j) = pack8(a, b); }
    }
    {   bf16_t* o = (bf16_t*)(ws + WS_DFTC);
        for (int it = gt; it < 1024 * 64; it += NGT) { const int n = it >> 6, i0 = (it & 63) * 8; float f[8];
#pragma unroll
            for (int j = 0; j < 8; ++j) { const int m = ((n & 511) * (i0 + j)) & 511; float s, c; sincospif((float)m * (1.0f / 256.0f), &s, &c); f[j] = (n < 512) ? c : s; }
            u32x4 w; w.x = cvt_pk_bf16(f[0], f[1]); w.y = cvt_pk_bf16(f[2], f[3]); w.z = cvt_pk_bf16(f[4], f[5]); w.w = cvt_pk_bf16(f[6], f[7]);
            *(u32x4*)(o + (size_t)n * 512 + i0) = w; }
    }
    {   const float* rw = p.in[I_RW]; const float* g2 = p.in[I_G2]; bf16_t* o = (bf16_t*)(ws + WS_RWT);
        for (int it = gt; it < 32 * 4096; it += NGT) { const int e = it >> 12, k = it & 4095; const float v = g2[k] * rw[k * 32 + e];
            const unsigned hi = cvt_pk_bf16(v, 0.f) & 0xffffu; const float lo = v - __uint_as_float(hi << 16);
            o[(size_t)e * 4096 + k] = (bf16_t)hi; o[(size_t)(32 + e) * 4096 + k] = (bf16_t)(cvt_pk_bf16(lo, 0.f) & 0xffffu); }
    }
}

__device__ __forceinline__ void p3_mix_prep(const Ctx& X) {
    const Params& p = *X.p; unsigned char* ws = p.ws;
    const bf16_t* u = (const bf16_t*)(ws + E_U); unsigned char* mixed = ws + E_MIXED;
    const int gt = X.bid * NTHREADS + X.tid, NGT = X.G * NTHREADS;
    constexpr int PP = 528;
    {   u32x4 ld[5];
        bf16_t* vv = (bf16_t*)(ws + E_VEVO);
        auto issue = [&](int w) { const int b = w >> 9, rem = w & 511, tt = rem >> 3, gc = rem & 7, g = gc >> 1, ch0 = g * 512 + (gc & 1) * 256, t0 = tt * 64;
#pragma unroll
            for (int i = 0; i < 5; ++i) { const int q = X.tid + 512 * i, rr = q >> 5, cq = q & 31, t = min(max(t0 - 8 + rr, 0), SEQ - 1);
                ld[i] = __builtin_nontemporal_load((const u32x4*)(u + (size_t)(b * SEQ + t) * DM + ch0 + cq * 8)); } };
        int w = X.bid; int it0 = gt;
        if (w < 2048) issue(w);
        while (w < 2048 || it0 < (NTOK / 2) * 256) {
            const bool dov = it0 < (NTOK / 2) * 256, dop = w < 2048;
            u32x4 va[4], vr[4];
            if (dov) {
#pragma unroll
                for (int k = 0; k < 4; ++k) { const int it = it0 + k * NGT, tokp = it >> 8, q = it & 255, b = tokp >> 11, sq = tokp & 2047, rs = (SEQ - sq) & (SEQ - 1);
                    va[k] = *(const u32x4*)(u + (size_t)(b * SEQ + sq) * DM + 2048 + q * 8); vr[k] = *(const u32x4*)(u + (size_t)(b * SEQ + rs) * DM + 2048 + q * 8); } }
            if (dop) {
                const int b = w >> 9, rem = w & 511, tt = rem >> 3, gc = rem & 7, g = gc >> 1, ch0 = g * 512 + (gc & 1) * 256;
                const int t0 = tt * 64, hw = 1 << g;
#pragma unroll
                for (int i = 0; i < 5; ++i) { const int q = X.tid + 512 * i, rr = q >> 5, cq = q & 31; if (rr < 79) *(LAS u32x4*)(X.lds + rr * PP + cq * 16) = ld[i]; }
                __syncthreads();
                if (w + X.G < 2048) issue(w + X.G);
                {
                    const int cq = X.tid & 31, tl0 = (X.tid >> 5) * 4;
                    float sm[8] = {0.f, 0.f, 0.f, 0.f, 0.f, 0.f, 0.f, 0.f};
                    {   const int t = t0 + tl0, lo = max(t - hw, 0), hi = min(t + hw - 1, SEQ - 1);
                        for (int r = lo; r <= hi; ++r) { const u32x4 v = *(const LAS u32x4*)(X.lds + (r - t0 + 8) * PP + cq * 16);
                            sm[0] += bf_lo(v.x); sm[1] += bf_hi(v.x); sm[2] += bf_lo(v.y); sm[3] += bf_hi(v.y); sm[4] += bf_lo(v.z); sm[5] += bf_hi(v.z); sm[6] += bf_lo(v.w); sm[7] += bf_hi(v.w); } }
#pragma unroll
                    for (int j = 0; j < 4; ++j) { const int tl = tl0 + j, t = t0 + tl;
                        if (j > 0) {
                            const int re = t - 1 + hw, rl = t - 1 - hw;
                            if (re <= SEQ - 1) { const u32x4 v = *(const LAS u32x4*)(X.lds + (re - t0 + 8) * PP + cq * 16);
                                sm[0] += bf_lo(v.x); sm[1] += bf_hi(v.x); sm[2] += bf_lo(v.y); sm[3] += bf_hi(v.y); sm[4] += bf_lo(v.z); sm[5] += bf_hi(v.z); sm[6] += bf_lo(v.w); sm[7] += bf_hi(v.w); }
                            if (rl >= 0) { const u32x4 v = *(const LAS u32x4*)(X.lds + (rl - t0 + 8) * PP + cq * 16);
                                sm[0] -= bf_lo(v.x); sm[1] -= bf_hi(v.x); sm[2] -= bf_lo(v.y); sm[3] -= bf_hi(v.y); sm[4] -= bf_lo(v.z); sm[5] -= bf_hi(v.z); sm[6] -= bf_lo(v.w); sm[7] -= bf_hi(v.w); } }
                        const int lo = max(t - hw, 0), hi = min(t + hw - 1, SEQ - 1);
                        const u32x4 cv = *(const LAS u32x4*)(X.lds + (tl + 8) * PP + cq * 16);
                        const float inv = 1.0f / (float)(hi - lo + 1);
                        const f32x4 o0 = {sm[0] * inv - bf_lo(cv.x), sm[1] * inv - bf_hi(cv.x), sm[2] * inv - bf_lo(cv.y), sm[3] * inv - bf_hi(cv.y)};
                        const f32x4 o1 = {sm[4] * inv - bf_lo(cv.z), sm[5] * inv - bf_hi(cv.z), sm[6] * inv - bf_lo(cv.w), sm[7] * inv - bf_hi(cv.w)};
                        *(u32x2*)(mixed + (size_t)(b * SEQ + t) * DM + ch0 + cq * 8) = g8::pack8_fp8(o0, o1); }
                }
            }
            if (dov) {
#pragma unroll
                for (int k = 0; k < 4; ++k) { const int it = it0 + k * NGT, tok = it >> 8, q = it & 255;
                    const u32x4 a = va[k], r = vr[k]; u32x4 e, o;
                    e.x = cvt_pk_bf16(0.5f * (bf_lo(a.x) + bf_lo(r.x)), 0.5f * (bf_hi(a.x) + bf_hi(r.x))); o.x = cvt_pk_bf16(0.5f * (bf_lo(a.x) - bf_lo(r.x)), 0.5f * (bf_hi(a.x) - bf_hi(r.x)));
                    e.y = cvt_pk_bf16(0.5f * (bf_lo(a.y) + bf_lo(r.y)), 0.5f * (bf_hi(a.y) + bf_hi(r.y))); o.y = cvt_pk_bf16(0.5f * (bf_lo(a.y) - bf_lo(r.y)), 0.5f * (bf_hi(a.y) - bf_hi(r.y)));
                    e.z = cvt_pk_bf16(0.5f * (bf_lo(a.z) + bf_lo(r.z)), 0.5f * (bf_hi(a.z) + bf_hi(r.z))); o.z = cvt_pk_bf16(0.5f * (bf_lo(a.z) - bf_lo(r.z)), 0.5f * (bf_hi(a.z) - bf_hi(r.z)));
                    e.w = cvt_pk_bf16(0.5f * (bf_lo(a.w) + bf_lo(r.w)), 0.5f * (bf_hi(a.w) + bf_hi(r.w))); o.w = cvt_pk_bf16(0.5f * (bf_lo(a.w) - bf_lo(r.w)), 0.5f * (bf_hi(a.w) - bf_hi(r.w)));
                    const int h = q >> 6, j = (q & 63) * 8;
                    *(u32x4*)(vv + (size_t)tok * DM + h * 1024 + j) = e; *(u32x4*)(vv + (size_t)tok * DM + h * 1024 + 512 + j) = o; }
            }
            if (dop) __syncthreads();
            w += X.G; it0 += 4 * NGT;
        }
    }
}

typedef short s16x4 __attribute__((ext_vector_type(4)));
constexpr int FT_PITCH = 544;
__device__ __forceinline__ bf16x8 fft_afrag(const LAS unsigned char* tile, int lane, int ks, int cb  ) {
    const int g = lane >> 4, q = (lane & 15) >> 2, pp = lane & 3;
    const LAS unsigned char* a0 = tile + (32 * ks + 8 * g + q) * FT_PITCH + (cb + 4 * pp) * 2;
    const s16x4 lo = __builtin_amdgcn_ds_read_tr16_b64_v4i16((LAS s16x4*)a0), hi = __builtin_amdgcn_ds_read_tr16_b64_v4i16((LAS s16x4*)(a0 + 4 * FT_PITCH));
    return __builtin_shufflevector(lo, hi, 0, 1, 2, 3, 4, 5, 6, 7);
}
__device__ __forceinline__ bf16x8 pack_frag(const float (&f)[8]) {
    u32x4 w; w.x = cvt_pk_bf16(f[0], f[1]); w.y = cvt_pk_bf16(f[2], f[3]); w.z = cvt_pk_bf16(f[4], f[5]); w.w = cvt_pk_bf16(f[6], f[7]); return __builtin_bit_cast(bf16x8, w);
}
__device__ __forceinline__ void p5a_fft1(const Ctx& X) {
    const Params& p = *X.p; unsigned char* ws = p.ws;
    const bf16_t* Q = (const bf16_t*)(ws + E_QT); bf16_t* T = (bf16_t*)(ws + E_T);
    LAS unsigned char* tile = X.lds; LAS float* cs = (LAS float*)(X.lds + 98304);
    if (X.tid < 64) { float sn, c; sincospif((float)X.tid * (1.0f / 32.0f), &sn, &c); cs[X.tid] = c; cs[64 + X.tid] = sn; }
    __syncthreads();
    const int fr = X.lane & 15, fq = X.lane >> 4, cbw = X.wave * 32;
    bf16x8 bfr[8][2];
#pragma unroll
    for (int ni = 0; ni < 8; ++ni)
#pragma unroll
        for (int ks = 0; ks < 2; ++ks) { float f[8];
#pragma unroll
            for (int j = 0; j < 8; ++j) { const int k1 = (16 * ni + fr) & 63, n1 = 32 * ks + 8 * fq + j, m = (k1 * n1) & 63; f[j] = (ni < 4) ? cs[m] : -cs[64 + m]; }
            bfr[ni][ks] = pack_frag(f); }
    u32x4 ld[4], lo[4];
    const bf16_t* Q2048 = (const bf16_t*)(ws + WS_PWT);
    int it = X.bid;
    auto issue = [&](int item) { const int b = item >> 9, n2 = (item >> 3) & 63, ch = item & 7;
#pragma unroll
        for (int i = 0; i < 4; ++i) { const int q = X.tid + 512 * i, n1 = q >> 5, pc = q & 31, sq = 64 * n1 + n2, sp = sq <= 2048 ? sq : SEQ - sq, col = ch * 256 + pc * 8;
            const bf16_t* pe = (sq == 2048) ? Q2048 + b * 2048 + col : Q + (size_t)(b * 2048 + sp) * 4096 + (col >> 9) * 1024 + (col & 511);
            ld[i] = __builtin_nontemporal_load((const u32x4*)pe); lo[i] = __builtin_nontemporal_load((const u32x4*)(sq == 2048 ? pe : pe + 512)); } };
    auto comb = [&](int i, int n2) -> u32x4 { const int q = X.tid + 512 * i, sq = 64 * (q >> 5) + n2; const float sg = sq < 2048 ? 1.0f : (sq == 2048 ? 0.0f : -1.0f);
        const u32x4 e = ld[i], o = lo[i]; u32x4 r;
        r.x = cvt_pk_bf16(bf_lo(e.x) + sg * bf_lo(o.x), bf_hi(e.x) + sg * bf_hi(o.x)); r.y = cvt_pk_bf16(bf_lo(e.y) + sg * bf_lo(o.y), bf_hi(e.y) + sg * bf_hi(o.y));
        r.z = cvt_pk_bf16(bf_lo(e.z) + sg * bf_lo(o.z), bf_hi(e.z) + sg * bf_hi(o.z)); r.w = cvt_pk_bf16(bf_lo(e.w) + sg * bf_lo(o.w), bf_hi(e.w) + sg * bf_hi(o.w)); return r; };
    if (it < 2048) issue(it);
    for (; it < 2048; it += X.G) {
        const int b = it >> 9, n2 = (it >> 3) & 63, ch = it & 7;
#pragma unroll
        for (int i = 0; i < 4; ++i) { const int q = X.tid + 512 * i; *(LAS u32x4*)(tile + (q >> 5) * FT_PITCH + (q & 31) * 16) = comb(i, n2); }
        __syncthreads();
        if (it + X.G < 2048) issue(it + X.G);
        f32x4 acc[2][8]; f32x4 zz = {0.f, 0.f, 0.f, 0.f}; asm volatile("" : "+v"(zz));
#pragma unroll
        for (int mf = 0; mf < 2; ++mf)
#pragma unroll
            for (int ni = 0; ni < 8; ++ni) acc[mf][ni] = zz;
#pragma unroll
        for (int mf = 0; mf < 2; ++mf)
#pragma unroll
            for (int ks = 0; ks < 2; ++ks) { const bf16x8 af = fft_afrag(tile, X.lane, ks, cbw + 16 * mf);
#pragma unroll
                for (int ni = 0; ni < 8; ++ni) if ((ni & 3) != 3) asm volatile("v_mfma_f32_16x16x32_bf16 %0, %1, %2, %0" : "+v"(acc[mf][ni]) : "v"(af), "v"(bfr[ni][ks])); }
        asm volatile("s_nop 15\n\ts_nop 15" ::: "memory");
#pragma unroll
        for (int ni = 0; ni < 3; ++ni) { const int k1 = 16 * ni + fr; if (k1 > 32) continue; const float rev = (float)(n2 * k1) * (1.0f / 4096.0f); const float sn = __builtin_amdgcn_sinf(rev), c = __builtin_amdgcn_cosf(rev);
            bf16_t* tr = T + ((size_t)((b * 64 + k1) * 64 + n2) * 2) * 2048 + ch * 256 + cbw + 4 * fq;
#pragma unroll
            for (int mf = 0; mf < 2; ++mf) { const f32x4 re = acc[mf][ni], im = acc[mf][ni + 4];
                const f32x4 t_r = re * c + im * sn, t_i = im * c - re * sn;
                u32x2 w; w.x = cvt_pk_bf16(t_r[0], t_r[1]); w.y = cvt_pk_bf16(t_r[2], t_r[3]); *(u32x2*)(tr + 16 * mf) = w;
                w.x = cvt_pk_bf16(t_i[0], t_i[1]); w.y = cvt_pk_bf16(t_i[2], t_i[3]); *(u32x2*)(tr + 2048 + 16 * mf) = w; } }
        __syncthreads();
    }
}
__device__ __forceinline__ void p5b_fft2(const Ctx& X) {
    const Params& p = *X.p; unsigned char* ws = p.ws;
    const bf16_t* T = (const bf16_t*)(ws + E_T); unsigned char* mixed = ws + E_MIXED;
    LAS unsigned char* tile = X.lds; LAS float* cs = (LAS float*)(X.lds + 98304);
    if (X.tid < 64) { float sn, c; sincospif((float)X.tid * (1.0f / 32.0f), &sn, &c); cs[X.tid] = c; cs[64 + X.tid] = sn; }
    __syncthreads();
    const int fr = X.lane & 15, fq = X.lane >> 4, cbw = X.wave * 32;
    const float sc = 1.0f / sqrtf((float)SEQ * 512.0f);
    bf16x8 bfr[4][4];
#pragma unroll
    for (int ni = 0; ni < 4; ++ni)
#pragma unroll
        for (int ks = 0; ks < 4; ++ks) { float f[8];
#pragma unroll
            for (int j = 0; j < 8; ++j) { const int k2 = 16 * ni + fr, kk = 32 * ks + 8 * fq + j, n2 = kk >> 1, m = (k2 * n2) & 63; const float c = cs[m], sn = cs[64 + m]; f[j] = ((kk & 1) ? (c + sn) : (c - sn)) * sc; }
            bfr[ni][ks] = pack_frag(f); }
    __builtin_amdgcn_sched_barrier(0);
    bf16x8 bfm[4][4];
#pragma unroll
    for (int ni = 0; ni < 4; ++ni)
#pragma unroll
        for (int ks = 0; ks < 4; ++ks) { float f[8];
#pragma unroll
            for (int j = 0; j < 8; ++j) { const int k2 = 16 * ni + fr, kk = 32 * ks + 8 * fq + j, n2 = kk >> 1, m = (k2 * n2) & 63; const float c = cs[m], sn = cs[64 + m]; f[j] = ((kk & 1) ? (sn - c) : (c + sn)) * sc; }
            bfm[ni][ks] = pack_frag(f); __builtin_amdgcn_sched_barrier(0); }
    u32x4 ld[8];
    int it = X.bid;
    constexpr int NIT = 4 * 33 * 8;
    auto imap = [&](int item, int& b, int& k1, int& ch) { if (item < 992) { b = item / 248; k1 = 1 + ((item % 248) >> 3); ch = item & 7; } else { const int j = item - 992; b = j >> 4; k1 = ((j >> 3) & 1) ? 32 : 0; ch = j & 7; } };
    auto issue = [&](int item) { int b, k1, ch; imap(item, b, k1, ch);
#pragma unroll
        for (int i = 0; i < 8; ++i) { const int q = X.tid + 512 * i, kk = q >> 5, pc = q & 31; ld[i] = __builtin_nontemporal_load((const u32x4*)(T + ((size_t)(b * 64 + k1) * 128 + kk) * 2048 + ch * 256 + pc * 8)); } };
    auto nxt = [&](int cur) { int n = cur + X.G; if (X.G == 256) { if (cur >= 1024) return (int)NIT; if (n >= 1024) n = X.bid >= 224 ? 1024 + X.bid - 224 : (int)NIT; } return n; };
    if (it < NIT) issue(it);
    for (; it < NIT; it = nxt(it)) {
        int b, k1, ch; imap(it, b, k1, ch); const bool mir = k1 != 0 && k1 != 32;
#pragma unroll
        for (int i = 0; i < 8; ++i) { const int q = X.tid + 512 * i; *(LAS u32x4*)(tile + (q >> 5) * FT_PITCH + (q & 31) * 16) = ld[i]; }
        __syncthreads();
        { const int nx = nxt(it); if (nx < NIT) issue(nx); }
#pragma unroll
        for (int pass = 0; pass < 2; ++pass) {
            if (pass == 1 && !mir) break;
            f32x4 acc[2][4]; f32x4 zz = {0.f, 0.f, 0.f, 0.f}; asm volatile("" : "+v"(zz));
#pragma unroll
            for (int mf = 0; mf < 2; ++mf)
#pragma unroll
                for (int ni = 0; ni < 4; ++ni) acc[mf][ni] = zz;
#pragma unroll
            for (int mf = 0; mf < 2; ++mf)
#pragma unroll
                for (int ks = 0; ks < 4; ++ks) { const bf16x8 af = fft_afrag(tile, X.lane, ks, cbw + 16 * mf);
#pragma unroll
                    for (int ni = 0; ni < 4; ++ni) { if (pass == 0) asm volatile("v_mfma_f32_16x16x32_bf16 %0, %1, %2, %0" : "+v"(acc[mf][ni]) : "v"(af), "v"(bfr[ni][ks]));
                                                     else asm volatile("v_mfma_f32_16x16x32_bf16 %0, %1, %2, %0" : "+v"(acc[mf][ni]) : "v"(af), "v"(bfm[ni][ks])); } }
            asm volatile("s_nop 15\n\ts_nop 15" ::: "memory");
#pragma unroll
            for (int ni = 0; ni < 4; ++ni) { const int k2 = 16 * ni + fr;
                const int krow = pass == 0 ? k1 + 64 * k2 : (64 - k1) + 64 * (63 - k2);
                unsigned char* o = mixed + (size_t)(b * SEQ + krow) * DM + 2048 + ch * 256 + cbw + 4 * fq;
#pragma unroll
                for (int mf = 0; mf < 2; ++mf) { const f32x4 v = acc[mf][ni]; int w = 0; w = __builtin_amdgcn_cvt_pk_fp8_f32(v[0], v[1], w, false); w = __builtin_amdgcn_cvt_pk_fp8_f32(v[2], v[3], w, true); *(int*)(o + 16 * mf) = w; } }
        }
        __syncthreads();
    }
}

__device__ __forceinline__ void p7_router(const Ctx& X, const size_t tb  , const size_t cb) {
    const Params& p = *X.p; unsigned char* ws = p.ws;
    const bf16_t* h1 = (const bf16_t*)(ws + WS_H1B); const bf16_t* rwt = (const bf16_t*)(ws + WS_RWT);
    int* rowtok = (int*)(ws + WS_ROWTOK + tb); float* rowrstd = (float*)(ws + WS_ROWRSTD + tb); float* rowgate = (float*)(ws + WS_ROWGATE + tb); int* rowdst = (int*)(ws + WS_ROWDST + tb);
    unsigned* gcnt = (unsigned*)(ws + WS_CTL + CTL_CNT + cb);
    LAS float* part = (LAS float*)X.lds;
    LAS float* ssq = (LAS float*)(X.lds + LX_RT);
    LAS int* lcnt = (LAS int*)(X.lds + LX_RT + 2048 + 8192);
    LAS int* gb = lcnt + 32;
    LAS float* gvs = (LAS float*)(X.lds + LX_RT + 2048 + 8192 + 512);
    for (int tt = X.bid; tt < NTOK / 64; tt += X.G) {
        int lzq = g8::lane_id_v();
        const int fr = lzq & 15, fq = lzq >> 4;
        const int tok0 = tt * 64;
        f32x4 acc[4][4]; float ss[4] = {0.f, 0.f, 0.f, 0.f};
#pragma unroll
        for (int a = 0; a < 4; ++a)
#pragma unroll
            for (int b = 0; b < 4; ++b) acc[a][b] = (f32x4){0.f, 0.f, 0.f, 0.f};
        {
        LAS unsigned char* wreg = X.lds + X.wave * 16384;
        const int l16 = lzq & 15, l4 = lzq >> 4;
        bf16x8 ld[16], bfb[4][4];
        const __amdgpu_buffer_rsrc_t rsH = __builtin_amdgcn_make_buffer_rsrc((void*)(h1 + (size_t)tok0 * DM), (short)0, (int)(64 * DM * 2), 0x00020000);
        const __amdgpu_buffer_rsrc_t rsR = __builtin_amdgcn_make_buffer_rsrc((void*)rwt, (short)0, (int)(64 * DM * 2), 0x00020000);
        const int vH = l4 * (DM * 2) + X.wave * 1024 + l16 * 16, vR = fr * (DM * 2) + X.wave * 1024 + fq * 16;
#define P7_GLOAD(q) do { _Pragma("unroll") for (int j = 0; j < 16; ++j) ld[j] = __builtin_bit_cast(bf16x8, __builtin_amdgcn_raw_buffer_load_b128(rsH, vH, j * (4 * DM * 2) + (q) * 256, 2)); } while (0)
        LAS unsigned char* wb[4]; LAS const unsigned char* rb[4];
#pragma unroll
        for (int jj = 0; jj < 4; ++jj) { const int row = 4 * jj + l4; wb[jj] = wreg + row * 256 + ((l16 ^ (row & 15)) * 16); rb[jj] = wreg + fr * 256 + (((jj * 4 + fq) ^ fr) * 16); }
#define P7_LWRITE() do { _Pragma("unroll") for (int j = 0; j < 16; ++j) *(LAS bf16x8*)(wb[j & 3] + (j >> 2) * 4096) = ld[j]; } while (0)
#define P7_BLOAD(st, kk) do { _Pragma("unroll") for (int ni = 0; ni < 4; ++ni) bfb[st][ni] = __builtin_bit_cast(bf16x8, __builtin_amdgcn_raw_buffer_load_b128(rsR, vR, ni * (16 * DM * 2) + (kk) * 64, 0)); } while (0)
        P7_GLOAD(0);
#pragma unroll 1
        for (int q = 0; q < 4; ++q) {
            P7_LWRITE();
            __builtin_amdgcn_sched_barrier(0);
            P7_BLOAD(0, q * 4); P7_BLOAD(1, q * 4 + 1); P7_BLOAD(2, q * 4 + 2); P7_BLOAD(3, q * 4 + 3);
            __builtin_amdgcn_sched_barrier(0);
            { const int qn = q < 3 ? q + 1 : 3; P7_GLOAD(qn); }
            __builtin_amdgcn_sched_barrier(0);
#pragma unroll
            for (int ks = 0; ks < 4; ++ks) {
                __builtin_amdgcn_sched_barrier(0);
#pragma unroll
                for (int mi = 0; mi < 4; ++mi) {
                    const bf16x8 af = *(const LAS bf16x8*)(rb[ks] + mi * 4096);
#pragma unroll
                    for (int j = 0; j < 8; ++j) { const float f = __uint_as_float(((unsigned)(unsigned short)af[j]) << 16); ss[mi] += f * f; }
#pragma unroll
                    for (int ni = 0; ni < 4; ++ni) asm volatile("v_mfma_f32_16x16x32_bf16 %0, %1, %2, %0" : "+v"(acc[mi][ni]) : "v"(af), "v"(bfb[ks & 3][ni]));
                }
                __builtin_amdgcn_sched_barrier(0);
            }
        }
        asm volatile("s_nop 15\n\ts_nop 15" ::: "memory");
        __builtin_amdgcn_s_waitcnt(0);
#undef P7_GLOAD
#undef P7_LWRITE
#undef P7_BLOAD
        }
        const int tq = X.wave * 64 + g8::lane_id_v();
#pragma unroll
        for (int mi = 0; mi < 4; ++mi) {
#pragma unroll
            for (int ni = 0; ni < 4; ++ni)
#pragma unroll
                for (int r = 0; r < 4; ++r) part[(X.wave * 64 + mi * 16 + 4 * fq + r) * 64 + ni * 16 + fr] = acc[mi][ni][r];
            float s = ss[mi]; s += __shfl_xor(s, 16); s += __shfl_xor(s, 32);
            if (fq == 0) ssq[X.wave * 64 + mi * 16 + fr] = s;
        }
        if (tq < 32) lcnt[tq] = 0;
        __syncthreads();
        int ei[4]; int lp[4]; float rstd_t;
        const int tk = tq >> 3, eg = tq & 7;
        {   float sq = 0.f;
#pragma unroll
            for (int w = 0; w < 8; ++w) sq += ssq[w * 64 + tk];
            const float rstd = rsqrtf(sq * (1.0f / DM) + RMS_EPS); rstd_t = rstd;
            float l4[4];
#pragma unroll
            for (int j = 0; j < 4; ++j) { const int e = eg * 4 + j; float a = 0.f;
#pragma unroll
                for (int w = 0; w < 8; ++w) a += part[(w * 64 + tk) * 64 + e] + part[(w * 64 + tk) * 64 + 32 + e];
                l4[j] = a * rstd + p.in[I_RB][e]; }
            float tv[4];
#pragma unroll
            for (int k = 0; k < 4; ++k) {
                float bv = l4[0]; int be = eg * 4;
#pragma unroll
                for (int j = 1; j < 4; ++j) if (l4[j] > bv) { bv = l4[j]; be = eg * 4 + j; }
#pragma unroll
                for (int o = 1; o < 8; o <<= 1) { const float ov = __shfl_xor(bv, o); const int oe = __shfl_xor(be, o); if (ov > bv || (ov == bv && oe < be)) { bv = ov; be = oe; } }
                tv[k] = bv; ei[k] = be;
#pragma unroll
                for (int j = 0; j < 4; ++j) if (be == eg * 4 + j) l4[j] = -3.0e38f;
            }
            if (eg == 0) {
                float gv[4], den = 0.f;
#pragma unroll
                for (int k = 0; k < 4; ++k) { gv[k] = __expf(tv[k] - tv[0]); den += gv[k]; }
                const float inv = 1.0f / den;
#pragma unroll
                for (int k = 0; k < 4; ++k) { gvs[tk * 4 + k] = gv[k] * inv; lp[k] = atomicAdd((int*)&lcnt[ei[k]], 1); }
            }
        }
        __syncthreads();
        if (tq < 32) { const int n = lcnt[tq]; gb[tq] = n ? (int)atomicAdd(&gcnt[tq], (unsigned)n) : 0; }
        __syncthreads();
        if (eg == 0) {
            const int tok = tok0 + tk;
#pragma unroll
            for (int k = 0; k < 4; ++k) { const int idx = ei[k] * CAP + gb[ei[k]] + lp[k];
                rowtok[idx] = tok; rowrstd[idx] = rstd_t; rowgate[idx] = gvs[tk * 4 + k]; rowdst[idx] = tok * 4 + k; }
        }
        __syncthreads();
    }
}

__device__ __forceinline__ int moe_tables(const Ctx& X) {
    const unsigned* gcnt = (const unsigned*)(X.p->ws + WS_CTL + CTL_CNT);
    LAS int* tab = (LAS int*)(X.lds + LX_RT);
    if (X.tid < 64) {
        const int e = X.lane & 31;
        const int c = (int)__hip_atomic_load(gcnt + e, __ATOMIC_RELAXED, __HIP_MEMORY_SCOPE_AGENT), nt = (c + 255) >> 8;
        int rb = c, ts = nt;
#pragma unroll
        for (int o = 1; o < 32; o <<= 1) { const int r2 = __shfl_up(rb, o), t2 = __shfl_up(ts, o); if (e >= o) { rb += r2; ts += t2; } }
        if (X.lane < 32) { const int rb0 = rb - c, ts0 = ts - nt;
            for (int j = 0; j < nt; ++j) { LAS int* r = tab + 4 + 4 * (ts0 + j); r[0] = e; r[1] = j; r[2] = c; r[3] = rb0; }
            if (e == 31) tab[0] = ts; }
    }
    __syncthreads();
    return __builtin_amdgcn_readfirstlane(tab[0]);
}

__device__ __forceinline__ void p10_combine(const Ctx& X) {
    const Params& p = *X.p; unsigned char* ws = p.ws;
    const bf16_t* h1 = (const bf16_t*)(ws + WS_H1B); const unsigned char* y = ws + E_Y; const float* gf = p.in[I_GF]; float* out = p.out;
    const int gw = X.bid * 8 + X.wave, NGW = X.G * 8;
    for (int tok = gw; tok < NTOK; tok += NGW) {
        float v[8][8]; float ss = 0.f;
#pragma unroll
        for (int ib = 0; ib < 8; ib += 4) {
            u32x4 a[4]; u32x2 yk[4][4];
#pragma unroll
            for (int ii = 0; ii < 4; ++ii) { const int c = ((ib + ii) * 64 + X.lane) * 8;
                a[ii] = __builtin_nontemporal_load((const u32x4*)(h1 + (size_t)tok * DM + c));
#pragma unroll
                for (int k = 0; k < 4; ++k) yk[ii][k] = __builtin_nontemporal_load((const u32x2*)(y + ((size_t)tok * 4 + k) * DM + c)); }
#pragma unroll
            for (int ii = 0; ii < 4; ++ii) { const int i = ib + ii; const u32x4 w = a[ii];
                float s8[8] = {0.f, 0.f, 0.f, 0.f, 0.f, 0.f, 0.f, 0.f};
#pragma unroll
                for (int k = 0; k < 4; ++k) {
                    const f32x2 p0 = __builtin_amdgcn_cvt_pk_f32_fp8((int)yk[ii][k].x, false), p1 = __builtin_amdgcn_cvt_pk_f32_fp8((int)yk[ii][k].x, true);
                    const f32x2 p2 = __builtin_amdgcn_cvt_pk_f32_fp8((int)yk[ii][k].y, false), p3 = __builtin_amdgcn_cvt_pk_f32_fp8((int)yk[ii][k].y, true);
                    s8[0] += p0.x; s8[1] += p0.y; s8[2] += p1.x; s8[3] += p1.y; s8[4] += p2.x; s8[5] += p2.y; s8[6] += p3.x; s8[7] += p3.y; }
                v[i][0] = bf_lo(w.x) + 0.125f * s8[0]; v[i][1] = bf_hi(w.x) + 0.125f * s8[1]; v[i][2] = bf_lo(w.y) + 0.125f * s8[2]; v[i][3] = bf_hi(w.y) + 0.125f * s8[3];
                v[i][4] = bf_lo(w.z) + 0.125f * s8[4]; v[i][5] = bf_hi(w.z) + 0.125f * s8[5]; v[i][6] = bf_lo(w.w) + 0.125f * s8[6]; v[i][7] = bf_hi(w.w) + 0.125f * s8[7];
#pragma unroll
                for (int j = 0; j < 8; ++j) ss += v[i][j] * v[i][j]; }
            asm volatile("" ::: "memory");
        }
        ss = wave_sum(ss);
        const float rstd = rsqrtf(ss * (1.0f / DM) + RMS_EPS);
#pragma unroll
        for (int i = 0; i < 8; ++i) { const int c = (i * 64 + X.lane) * 8;
            const f32x4 g0 = *(const f32x4*)(gf + c), g1 = *(const f32x4*)(gf + c + 4);
            f32x4 o0, o1;
#pragma unroll
            for (int j = 0; j < 4; ++j) { o0[j] = v[i][j] * rstd * g0[j]; o1[j] = v[i][4 + j] * rstd * g1[j]; }
            __builtin_nontemporal_store(o0, (f32x4*)(out + (size_t)tok * DM + c)); __builtin_nontemporal_store(o1, (f32x4*)(out + (size_t)tok * DM + c + 4)); }
    }
}

__global__ void __launch_bounds__(NTHREADS, 2) mk_fwd(Params prm) {
    extern __shared__ __attribute__((aligned(16))) unsigned char lds_raw[];
    Ctx X; X.p = &prm; X.lds = (LAS unsigned char*)lds_raw; X.tid = threadIdx.x; X.lane = X.tid & 63; X.wave = __builtin_amdgcn_readfirstlane(X.tid >> 6); X.G = gridDim.x; X.bid = blockIdx.x;
#define RECTX() do { int _lz = (int)__builtin_amdgcn_mbcnt_hi(~0u, __builtin_amdgcn_mbcnt_lo(~0u, 0u)); asm volatile("" : "+v"(_lz)); X.lane = _lz; X.tid = X.wave * 64 + _lz; } while (0)
    unsigned char* ws = prm.ws;
    const int lo = prm.ph_lo, hi = prm.ph_hi;
#if !MK_PER_PHASE
    if (X.tid == 0) *(LAS u32x4*)(X.lds + LX_BAR) = (u32x4){0u, 0u, 0u, 0u};
    __syncthreads();
    XcdBarrier bar = xcd_barrier_post((unsigned*)(ws + WS_CTL), (volatile LAS unsigned*)(X.lds + LX_BAR));
#define GRID_BAR() xcd_barrier(bar, X.wave == 0 && g8::lane_id_v() == 0)
#else
#define GRID_BAR() do {} while (0)
#endif
#ifdef MK_ONLY
#define IN(k) ((k) == MK_ONLY)
#else
#define IN(k) (lo <= (k) && (k) < hi)
#endif
#define SEAM(k) do { if (IN((k) + 1)) GRID_BAR(); } while (0)
    LAS unsigned char* stage = X.lds;

    if (IN(0)) { RECTX(); p0_prep(X); if (MK_DOUBLE == 0) { __syncthreads(); p0_prep(X); } SEAM(0); }

    if (IN(1)) {
        {   g8::DenseP<0> P{}; P.A = (const char*)(ws + WS_PWT); P.B = (const char*)(ws + E_WINP); P.C = (bf16_t*)(ws + E_WINT);
            P.lda2 = 1024; P.ldb2 = 4096; P.nt = 8; P.nM = 8; P.nN = 16; P.G = X.G; P.c = X.bid; P.mPer = 2; P.bDiv = 1; P.ldc = 4096;
            P.aHi = 512 * 512 * 2; P.aLo = 0; P.bHi = 512 * 2; P.bLo = 0; P.cHi = (size_t)512 * 4096; P.cLo = 0; P.rowscale = nullptr; P.resid = nullptr;
            g8::gemm_phase(stage, P, X.wave); }
        {   g8::DenseP<0> P{}; P.A = (const char*)(ws + WS_FWT); P.B = (const char*)(ws + WS_DFTC); P.C = (bf16_t*)(ws + WS_GT);
            P.lda2 = 1024; P.ldb2 = 1024; P.nt = 8; P.nM = 8; P.nN = 4; P.G = X.G; P.c = (X.bid + 128) % X.G; P.mPer = 2; P.bDiv = 1; P.ldc = 1024;
            P.aHi = 512 * 512 * 2; P.aLo = 0; P.bHi = 0; P.bLo = 0; P.cHi = (size_t)512 * 1024; P.cLo = 0; P.rowscale = nullptr; P.resid = nullptr;
            g8::gemm_phase(stage, P, X.wave); }
        SEAM(1);
    }

    if (IN(2)) { RECTX();
        g8::DenseP<1, false, 1> P{}; P.A = (const char*)(ws + E_XB); P.B = (const char*)(ws + E_WINT); P.C = (bf16_t*)(ws + E_U);
        P.lda2 = 8192; P.ldb2 = 8192; P.nt = 64; P.nM = 64; P.nN = 16; P.G = X.G; P.c = X.bid; P.mPer = 64; P.bDiv = 1; P.ldc = 4096;
        P.aHi = 0; P.aLo = 0; P.bHi = 0; P.bLo = 0; P.cHi = 0; P.cLo = 0; P.rowscale = (const float*)(ws + WS_RSTD1); P.resid = nullptr;
        const int nun = X.bid < 64 * 16 ? (64 * 16 - X.bid + X.G - 1) / X.G : 0, per = X.bid < T8_WD ? (T8_WD - X.bid + X.G - 1) / X.G : 0, inl = min(per, nun * 64 / 8);
        P.ssrc0 = prm.in[I_WG]; P.ssrc1 = prm.in[I_WU]; P.sdst = ws + WS_WGU; P.sbid = X.bid; P.sk1 = inl;
        for (int rep = 0; rep < (MK_DOUBLE == 2 ? 2 : 1); ++rep) g8::gemm_phase(stage, P, X.wave);
        RECTX(); convert_tiles8(X, 0, T8_WD, inl, 1 << 30);
        SEAM(2);
    }

    if (IN(3)) { RECTX(); p3_mix_prep(X); if (MK_DOUBLE == 3) { __syncthreads(); p3_mix_prep(X); } SEAM(3); }

    if (IN(4)) {
        g8::DenseP<0, false, 3> P{}; P.A = (const char*)(ws + E_VEVO); P.B = (const char*)(ws + WS_GT); P.C = (bf16_t*)(ws + E_QT);
        P.lda2 = 8192; P.ldb2 = 2048; P.nt = 8; P.nM = 256; P.nN = 2; P.G = X.G; P.c = X.bid; P.mPer = 32; P.bDiv = 2; P.ldc = 4096;
        P.aHi = 1024 * 2; P.aLo = 512 * 2; P.bHi = 512 * 1024 * 2; P.bLo = 512 * 2; P.cHi = 1024; P.cLo = 512; P.rowscale = nullptr; P.resid = nullptr;
        const int nun = X.bid < 512 ? (512 - X.bid + X.G - 1) / X.G : 0, per = X.bid < NT_WOUT ? (NT_WOUT - X.bid + X.G - 1) / X.G : 0, inl = min(per, nun * 8 / 8);
        P.ssrc0 = prm.in[I_WOUT]; P.ssrc1 = nullptr; P.sdst = ws + E_WOUTT; P.sbid = X.bid; P.sk1 = inl;
        for (int rep = 0; rep < (MK_DOUBLE == 4 ? 2 : 1); ++rep) g8::gemm_phase(stage, P, X.wave);
        RECTX(); convert_tiles8(X, NT_F8, T8_WOUT_END, inl, 1 << 30);
        {
            const int sub = X.tid & 15;
            for (int o = X.bid * 32 + (X.tid >> 4); o < 4 * 2048; o += X.G * 32) { const int b = o >> 11, col = o & 2047, h = col >> 9, c = col & 511;
                const bf16_t* uv = (const bf16_t*)(ws + E_U) + (size_t)(b * SEQ + 2048) * DM + 2048 + h * 512 + sub * 32;
                const bf16_t* gr = (const bf16_t*)(ws + WS_GT) + ((size_t)h * 512 + c) * 1024 + sub * 32; float a = 0.f;
#pragma unroll
                for (int k = 0; k < 32; k += 8) { const u32x4 x = *(const u32x4*)(uv + k), g = *(const u32x4*)(gr + k);
                    a += bf_lo(x.x) * bf_lo(g.x) + bf_hi(x.x) * bf_hi(g.x) + bf_lo(x.y) * bf_lo(g.y) + bf_hi(x.y) * bf_hi(g.y) + bf_lo(x.z) * bf_lo(g.z) + bf_hi(x.z) * bf_hi(g.z) + bf_lo(x.w) * bf_lo(g.w) + bf_hi(x.w) * bf_hi(g.w); }
                a += __shfl_xor(a, 1); a += __shfl_xor(a, 2); a += __shfl_xor(a, 4); a += __shfl_xor(a, 8);
                if (sub == 0) ((bf16_t*)(ws + WS_PWT))[b * 2048 + col] = (bf16_t)(cvt_pk_bf16(a, 0.f) & 0xffffu); } }
        SEAM(4);
    }

    if (IN(5)) { RECTX();
        p5a_fft1(X);
        GRID_BAR();
        RECTX(); p5b_fft2(X);
        SEAM(5);
    }

    if (IN(6)) { RECTX();
        g8::DenseP<2, true, 2> P{}; P.A = (const char*)(ws + E_MIXED); P.B = (const char*)(ws + E_WOUTT); P.C = (bf16_t*)(ws + WS_H1B); P.C8 = ws + WS_H1F8; P.oscale = 1.0f / 64.0f;
        P.lda2 = 4096; P.ldb2 = 4096; P.nt = 32; P.nM = 64; P.nN = 16; P.G = X.G; P.c = X.bid; P.mPer = 64; P.bDiv = 1; P.ldc = 4096;
        P.aHi = 0; P.aLo = 0; P.bHi = 0; P.bLo = 0; P.cHi = 0; P.cLo = 0; P.rowscale = prm.in[I_G2]; P.resid = nullptr; P.residb = (const bf16_t*)(ws + E_XB);
        const int nun = X.bid < 64 * 16 ? (64 * 16 - X.bid + X.G - 1) / X.G : 0, per = X.bid < NT_EXP ? (NT_EXP - X.bid + X.G - 1) / X.G : 0, inl = min(per, nun * 32 / 8);
        P.ssrc0 = prm.in[I_WD]; P.ssrc1 = nullptr; P.sdst = ws + WS_WD; P.sbid = X.bid; P.sk1 = inl;
        for (int rep = 0; rep < (MK_DOUBLE == 6 ? 2 : 1); ++rep) g8::gemm_phase(stage, P, X.wave);
        RECTX(); convert_tiles8(X, T8_WD, NT_F8, inl, 1 << 30);
        SEAM(6);
    }

    if (IN(7)) { RECTX(); p7_router(X, 0, 0);
#if MK_DOUBLE == 7
        __syncthreads(); p7_router(X, E_U - WS_ROWTOK, 4096);
#endif
        SEAM(7); }

    if (IN(8)) { RECTX();
        const int T = moe_tables(X);
        g8::MoeGateUpP P{}; P.m0 = 0; P.nMv = T < 256 ? T : 256; P.A = (const char*)(ws + WS_H1F8); P.B = (const char*)(ws + WS_WGU); P.lda2 = 4096; P.ldb2 = 4096; P.nt = 32; P.G = X.G; P.c = X.bid;
        P.tab = (LAS const int*)(X.lds + LX_RT); P.rowtok = (const int*)(ws + WS_ROWTOK); P.rowrstd = (const float*)(ws + WS_ROWRSTD);
        P.bgate = prm.in[I_BG]; P.bup = prm.in[I_BU]; P.act = ws + WS_ACT; P.preload();
        for (int rep = 0; rep < (MK_DOUBLE == 8 ? 2 : 1); ++rep) g8::gemm_phase(stage, P, X.wave);
        SEAM(8);
    }

    if (IN(9)) { RECTX();
        const int T = __builtin_amdgcn_readfirstlane(*(LAS const int*)(X.lds + LX_RT));
        const int Lr = T > 256 ? T - 256 : 0;
        if (Lr > 0) {
            g8::MoeGateUpP P{}; P.m0 = 256; P.nMv = Lr; P.A = (const char*)(ws + WS_H1F8); P.B = (const char*)(ws + WS_WGU); P.lda2 = 4096; P.ldb2 = 4096; P.nt = 32; P.G = X.G; P.c = X.bid;
            P.tab = (LAS const int*)(X.lds + LX_RT); P.rowtok = (const int*)(ws + WS_ROWTOK); P.rowrstd = (const float*)(ws + WS_ROWRSTD);
            P.bgate = prm.in[I_BG]; P.bup = prm.in[I_BU]; P.act = ws + WS_ACT; P.preload();
            g8::gemm_phase(stage, P, X.wave);
        }
        {   g8::MoeDownP P{}; P.mode = 0; P.nbusy = (4 * Lr < X.G) ? 4 * Lr : X.G; P.m0 = 0; P.nMv = T < 256 ? T : 256;
            P.A = (const char*)(ws + WS_ACT); P.B = (const char*)(ws + WS_WD); P.lda2 = 512; P.ldb2 = 512; P.nt = 4; P.G = X.G; P.c = X.bid;
            P.tab = (LAS const int*)(X.lds + LX_RT); P.rowdst = (const int*)(ws + WS_ROWDST); P.rowgate = (const float*)(ws + WS_ROWGATE);
            P.bdown = prm.in[I_BD]; P.y = ws + E_Y; P.preload();
            for (int rep = 0; rep < (MK_DOUBLE == 9 ? 2 : 1); ++rep) g8::gemm_phase(stage, P, X.wave); }
        if (Lr > 0) {
            GRID_BAR();
            g8::MoeDownP P{}; P.mode = 1; P.nbusy = 0; P.m0 = 256; P.nMv = Lr;
            P.A = (const char*)(ws + WS_ACT); P.B = (const char*)(ws + WS_WD); P.lda2 = 512; P.ldb2 = 512; P.nt = 4; P.G = X.G; P.c = X.bid;
            P.tab = (LAS const int*)(X.lds + LX_RT); P.rowdst = (const int*)(ws + WS_ROWDST); P.rowgate = (const float*)(ws + WS_ROWGATE);
            P.bdown = prm.in[I_BD]; P.y = ws + E_Y; P.preload();
            g8::gemm_phase(stage, P, X.wave);
        }
        SEAM(9);
    }

    if (IN(10)) { RECTX(); p10_combine(X); if (MK_DOUBLE == 10) { __syncthreads(); p10_combine(X); } }
#undef RECTX
#undef IN
#undef SEAM
#undef GRID_BAR
}

extern "C" void kernel_launch(void* const* d_in, const int* in_sizes, int n_in, void* d_out, int out_size, void* d_ws, size_t ws_size, hipStream_t stream) {
    static int grid = 0;
    if (grid == 0) {
        if (n_in != 17 || in_sizes[0] != NTOK * DM || out_size != NTOK * DM || ws_size < WS_END) { fprintf(stderr, "kernel_launch: unexpected shapes / workspace (n_in %d, ws %zu, need %zu); nothing launched\n", n_in, ws_size, (size_t)WS_END); grid = -1; return; }
        int dev = 0, cus = 0, per_cu = 0;
        if (hipGetDevice(&dev) != hipSuccess || hipDeviceGetAttribute(&cus, hipDeviceAttributeMultiprocessorCount, dev) != hipSuccess) { grid = -1; return; }
        if (hipFuncSetAttribute((const void*)mk_fwd, hipFuncAttributeMaxDynamicSharedMemorySize, LDS_BYTES) != hipSuccess) { fprintf(stderr, "kernel_launch: hipFuncSetAttribute failed\n"); grid = -1; return; }
        if (hipOccupancyMaxActiveBlocksPerMultiprocessor(&per_cu, (const void*)mk_fwd, NTHREADS, LDS_BYTES) != hipSuccess || per_cu < 1) { fprintf(stderr, "kernel_launch: occupancy query says %d\n", per_cu); (void)hipGetLastError(); per_cu = 1; }
        grid = cus;
    }
    if (grid < 0) return;
    if (hipMemsetAsync((char*)d_ws + WS_CTL, 0, CTL_BYTES, stream) != hipSuccess) return;
    Params a{};
    for (int i = 0; i < 17; ++i) a.in[i] = (const float*)d_in[i];
    a.out = (float*)d_out; a.ws = (unsigned char*)d_ws;
#if MK_PER_PHASE
    for (int ph = 0; ph < NPHASES; ++ph) { a.ph_lo = ph; a.ph_hi = ph + 1; hipLaunchKernelGGL(mk_fwd, dim3(grid), dim3(NTHREADS), LDS_BYTES, stream, a); }
#else
    a.ph_lo = 0; a.ph_hi = NPHASES;
    hipLaunchKernelGGL(mk_fwd, dim3(grid), dim3(NTHREADS), LDS_BYTES, stream, a);
#endif
}
```
